# Optimizing an MI355X kernel written in HIP

```python
import math
import jax, jax.numpy as jnp
from jax import lax
import numpy as np

D_MODEL = 2048
BATCH = 8
SEQ = 2048
DEPTH = 2

N_EVEN = (DEPTH + 1) // 2
N_ODD = DEPTH // 2
MIX_HALF = D_MODEL // 2
Q_BLOCK = 128
MAX_POS_OFFSET = 1024
RMS_EPS = 1e-6

MLA_NOPE = 128
MLA_ROPE = 64
MLA_V = 128
MLA_HEADS = MIX_HALF // MLA_V
MLA_Q_RANK = D_MODEL // 4
MLA_KV_RANK = D_MODEL // 4
ROPE_THETA = 10000.0

GLA_HEADS = 4
GLA_DK = MIX_HALF // 2 // GLA_HEADS
GLA_DV = MIX_HALF // GLA_HEADS
GLA_GATE_RANK = 16
GLA_GATE_NORM = 16.0
GLA_CHUNK = 64

S5_WIDTH = MIX_HALF
S5_GROUP = 16
S5_GROUPS = S5_WIDTH // S5_GROUP
S5_STATE = 64
S5_DT_MIN = 0.001
S5_DT_MAX = 0.1

DIFF_DQK = 64
DIFF_DV = 2 * DIFF_DQK
DIFF_HEADS = MIX_HALF // DIFF_DV

FFN_HIDDEN = -(-8 * D_MODEL // (3 * 256)) * 256

EVEN_SIZES = (MLA_Q_RANK, MLA_KV_RANK, MLA_ROPE,
              GLA_HEADS * GLA_DK, GLA_HEADS * GLA_DK, GLA_HEADS * GLA_DV,
              GLA_GATE_RANK, GLA_HEADS * GLA_DV)
EVEN_COLS = (MLA_Q_RANK + MLA_KV_RANK + MLA_ROPE + 2 * GLA_HEADS * GLA_DK
             + 2 * GLA_HEADS * GLA_DV + GLA_GATE_RANK)
ODD_SIZES = (S5_WIDTH, DIFF_HEADS * 2 * DIFF_DQK, DIFF_HEADS * 2 * DIFF_DQK, DIFF_HEADS * DIFF_DV)
ODD_COLS = S5_WIDTH + 4 * DIFF_HEADS * DIFF_DQK + DIFF_HEADS * DIFF_DV

kernel_name = 'hybrid_mla_gla_s5_diffattn'


def rms_norm(x, g):
    xf = x.astype(jnp.float32)
    y = xf * lax.rsqrt(jnp.mean(xf * xf, axis=-1, keepdims=True) + RMS_EPS)
    return y.astype(x.dtype) * g


def split_cols(t, sizes):
    idx, acc = [], 0
    for s in sizes[:-1]:
        acc += s
        idx.append(acc)
    return jnp.split(t, idx, axis=-1)


def apply_rope(t, pos):
    half = t.shape[-1] // 2
    inv_freq = ROPE_THETA ** (-jnp.arange(half, dtype=jnp.float32) / half)
    ang = pos.astype(jnp.float32)[..., None] * inv_freq
    ang = ang.reshape(ang.shape[:2] + (1,) * (t.ndim - 3) + (half,))
    cos, sin = jnp.cos(ang), jnp.sin(ang)
    tf = t.astype(jnp.float32)
    t1, t2 = tf[..., :half], tf[..., half:]
    return jnp.concatenate([t1 * cos - t2 * sin, t2 * cos + t1 * sin], axis=-1).astype(t.dtype)


def to_blocks(t):
    b, s = t.shape[:2]
    return jnp.moveaxis(t.reshape((b, s // Q_BLOCK, Q_BLOCK) + t.shape[2:]), 1, 0)


def from_blocks(t):
    nb, b = t.shape[:2]
    return jnp.moveaxis(t, 0, 1).reshape((b, nb * t.shape[2]) + t.shape[3:])


def alibi_slopes(n_heads):
    return jnp.exp2(-8.0 * jnp.arange(1, n_heads + 1, dtype=jnp.float32) / n_heads)


def mla_attention(q_nope, q_rope, k_nope, k_rope, v):
    s_len = q_nope.shape[1]
    scale = (MLA_NOPE + MLA_ROPE) ** -0.5
    k_idx = jnp.arange(s_len)

    def block(args):
        qn, qr, start = args
        s = (jnp.einsum('bqhd,bkhd->bhqk', qn, k_nope)
             + jnp.einsum('bqhd,bkd->bhqk', qr, k_rope)).astype(jnp.float32) * scale
        mask = k_idx[None, :] <= (start + jnp.arange(Q_BLOCK))[:, None]
        p = jax.nn.softmax(jnp.where(mask, s, -jnp.inf), axis=-1).astype(v.dtype)
        return jnp.einsum('bhqk,bkhd->bqhd', p, v)

    starts = jnp.arange(s_len // Q_BLOCK, dtype=jnp.int32) * Q_BLOCK
    out = lax.map(block, (to_blocks(q_nope), to_blocks(q_rope), starts))
    return from_blocks(out)


def gla_chunked(q, k, v, log_a):
    b, s_len, h, dk = q.shape
    dv = v.shape[-1]
    nc = s_len // GLA_CHUNK

    def chunks(t):
        return t.reshape(b, nc, GLA_CHUNK, h, t.shape[-1]).transpose(1, 0, 3, 2, 4)

    causal = jnp.tril(jnp.ones((GLA_CHUNK, GLA_CHUNK), dtype=bool))[None, None, :, :, None]

    def step(state, inp):
        qc, kc, vc, gc = inp
        cum = jnp.cumsum(gc, axis=2)
        o_inter = jnp.einsum('bhid,bhde->bhie', qc * jnp.exp(cum), state)
        rel = cum[:, :, :, None, :] - cum[:, :, None, :, :]
        decay = jnp.exp(jnp.where(causal, rel, -jnp.inf))
        attn = jnp.einsum('bhid,bhjd,bhijd->bhij', qc, kc, decay)
        o_intra = jnp.einsum('bhij,bhje->bhie', attn, vc)
        last = cum[:, :, -1:, :]
        new_state = (jnp.exp(last[:, :, 0, :])[..., None] * state
                     + jnp.einsum('bhjd,bhje->bhde', kc * jnp.exp(last - cum), vc))
        return new_state, o_inter + o_intra

    state0 = jnp.zeros((b, h, dk, dv), jnp.float32)
    _, out = lax.scan(step, state0, (chunks(q), chunks(k), chunks(v), chunks(log_a)))
    return out.transpose(1, 0, 3, 2, 4).reshape(b, s_len, h, dv)


def _complex_affine_combine(e1, e2):
    a1r, a1i, b1r, b1i = e1
    a2r, a2i, b2r, b2i = e2
    return (a2r * a1r - a2i * a1i, a2r * a1i + a2i * a1r,
            a2r * b1r - a2i * b1i + b2r, a2r * b1i + a2i * b1r + b2i)


def s5_mixer(u, a_re, a_im, log_dt, b_re, b_im, c_re, c_im, d_skip, w_glu, b_glu):
    f32 = jnp.float32
    bsz, s_len, _ = u.shape
    uf = u.astype(f32).reshape(bsz, s_len, S5_GROUPS, S5_GROUP)
    dt = jnp.exp(log_dt.astype(f32))[:, None]
    lr, li = a_re.astype(f32), a_im.astype(f32)
    mag = jnp.exp(lr * dt)
    abar_r, abar_i = mag * jnp.cos(li * dt), mag * jnp.sin(li * dt)
    den = lr * lr + li * li
    zr, zi = abar_r - 1.0, abar_i
    fr = (zr * lr + zi * li) / den
    fi = (zi * lr - zr * li) / den
    br, bi = b_re.astype(f32), b_im.astype(f32)
    bbar_r = fr[..., None] * br - fi[..., None] * bi
    bbar_i = fr[..., None] * bi + fi[..., None] * br
    bu_r = jnp.einsum('gnp,bsgp->bsgn', bbar_r, uf)
    bu_i = jnp.einsum('gnp,bsgp->bsgn', bbar_i, uf)
    a_r = jnp.broadcast_to(abar_r, (1, s_len, S5_GROUPS, S5_STATE))
    a_i = jnp.broadcast_to(abar_i, (1, s_len, S5_GROUPS, S5_STATE))
    _, _, x_r, x_i = lax.associative_scan(_complex_affine_combine, (a_r, a_i, bu_r, bu_i), axis=1)
    y = (jnp.einsum('gpn,bsgn->bsgp', c_re.astype(f32), x_r)
         - jnp.einsum('gpn,bsgn->bsgp', c_im.astype(f32), x_i)
         + d_skip.astype(f32) * uf).reshape(bsz, s_len, S5_WIDTH)
    z = jax.nn.gelu(y)
    out = z * jax.nn.sigmoid(z @ w_glu.astype(f32) + b_glu.astype(f32))
    return out.astype(u.dtype)


def diff_attention(q, k, v, pos, lam, slopes):
    s_len = q.shape[1]
    scale = DIFF_DQK ** -0.5
    k_idx = jnp.arange(s_len)

    def block(args):
        qb, pb, start = args
        s = jnp.einsum('bqhcd,bkhcd->bhcqk', qb, k).astype(jnp.float32) * scale
        dist = jnp.abs(pb[:, :, None] - pos[:, None, :]).astype(jnp.float32)
        s = s - slopes[None, :, None, None, None] * dist[:, None, None]
        mask = k_idx[None, :] <= (start + jnp.arange(Q_BLOCK))[:, None]
        p = jax.nn.softmax(jnp.where(mask, s, -jnp.inf), axis=-1)
        attn = (p[:, :, 0] - lam * p[:, :, 1]).astype(v.dtype)
        return jnp.einsum('bhqk,bkhd->bqhd', attn, v)

    starts = jnp.arange(s_len // Q_BLOCK, dtype=jnp.int32) * Q_BLOCK
    out = lax.map(block, (to_blocks(q), to_blocks(pos), starts))
    return from_blocks(out)


def mla_gla_mixer(hn, pos, w_in, q_norm, w_uq, kv_norm, w_ukv, w_gate_up, b_gate, g_norm, w_out):
    bsz, s_len, _ = hn.shape
    c_q, c_kv, k_rope, g_q, g_k, g_v, g_lr, g_out = split_cols(hn @ w_in, EVEN_SIZES)
    q = (rms_norm(c_q, q_norm) @ w_uq).reshape(bsz, s_len, MLA_HEADS, MLA_NOPE + MLA_ROPE)
    q_nope, q_rope = q[..., :MLA_NOPE], apply_rope(q[..., MLA_NOPE:], pos)
    kv = (rms_norm(c_kv, kv_norm) @ w_ukv).reshape(bsz, s_len, MLA_HEADS, MLA_NOPE + MLA_V)
    k_nope, v = kv[..., :MLA_NOPE], kv[..., MLA_NOPE:]
    o_mla = mla_attention(q_nope, q_rope, k_nope, apply_rope(k_rope, pos), v)
    o_mla = o_mla.reshape(bsz, s_len, MLA_HEADS * MLA_V)
    f32 = jnp.float32
    gq = g_q.reshape(bsz, s_len, GLA_HEADS, GLA_DK).astype(f32) * GLA_DK ** -0.5
    gk = g_k.reshape(bsz, s_len, GLA_HEADS, GLA_DK).astype(f32)
    gv = g_v.reshape(bsz, s_len, GLA_HEADS, GLA_DV).astype(f32)
    log_a = jax.nn.log_sigmoid((g_lr @ w_gate_up + b_gate).astype(f32)) / GLA_GATE_NORM
    log_a = log_a.reshape(bsz, s_len, GLA_HEADS, GLA_DK)
    o = rms_norm(gla_chunked(gq, gk, gv, log_a).astype(hn.dtype), g_norm)
    o_gla = o.reshape(bsz, s_len, GLA_HEADS * GLA_DV) * jax.nn.silu(g_out)
    return jnp.concatenate([o_mla, o_gla], axis=-1) @ w_out


def s5_diff_mixer(hn, pos, slopes, lambda_init, w_in, a_re, a_im, log_dt, b_re, b_im, c_re, c_im,
                  d_skip, w_glu, b_glu, lq1, lk1, lq2, lk2, d_norm, w_out):
    bsz, s_len, _ = hn.shape
    u, dq, dk, dv = split_cols(hn @ w_in, ODD_SIZES)
    o_s5 = s5_mixer(u, a_re, a_im, log_dt, b_re, b_im, c_re, c_im, d_skip, w_glu, b_glu)
    f32 = jnp.float32
    lam = (jnp.exp(jnp.sum(lq1.astype(f32) * lk1.astype(f32)))
           - jnp.exp(jnp.sum(lq2.astype(f32) * lk2.astype(f32))) + lambda_init)
    q = dq.reshape(bsz, s_len, DIFF_HEADS, 2, DIFF_DQK)
    k = dk.reshape(bsz, s_len, DIFF_HEADS, 2, DIFF_DQK)
    v = dv.reshape(bsz, s_len, DIFF_HEADS, DIFF_DV)
    o = rms_norm(diff_attention(q, k, v, pos, lam, slopes), d_norm) * (1.0 - lambda_init)
    o_diff = o.reshape(bsz, s_len, DIFF_HEADS * DIFF_DV)
    return jnp.concatenate([o_s5, o_diff], axis=-1) @ w_out


def swiglu(h, w_gate, w_up, w_down):
    return (jax.nn.silu(h @ w_gate) * (h @ w_up)) @ w_down


def setup_inputs(seed: int = 0) -> dict:
    key = jax.random.key(seed)
    keys = jax.random.split(key, 48)
    counter = [0]
    f32 = jnp.float32

    def nk():
        counter[0] += 1
        return keys[counter[0] - 1]

    def nrm(shape, fan_in):
        return jax.random.normal(nk(), shape, f32) * fan_in ** -0.5

    def gain(shape):
        return 1.0 + 0.02 * jax.random.normal(nk(), shape, f32)

    def small(shape, s):
        return s * jax.random.normal(nk(), shape, f32)

    x = jax.random.normal(nk(), (BATCH, SEQ, D_MODEL), f32)
    positions = (jax.random.randint(nk(), (BATCH, 1), 0, MAX_POS_OFFSET, dtype=jnp.int32)
                 + jnp.arange(SEQ, dtype=jnp.int32)[None, :])
    n_idx = jnp.arange(S5_STATE, dtype=f32)
    return {
        'x': x,
        'positions': positions,
        'norm_mix': gain((DEPTH, D_MODEL)),
        'norm_ffn': gain((DEPTH, D_MODEL)),
        'final_norm': gain((D_MODEL,)),
        'ffn_w_gate': nrm((DEPTH, D_MODEL, FFN_HIDDEN), D_MODEL),
        'ffn_w_up': nrm((DEPTH, D_MODEL, FFN_HIDDEN), D_MODEL),
        'ffn_w_down': nrm((DEPTH, FFN_HIDDEN, D_MODEL), FFN_HIDDEN),
        'ag_w_in': nrm((N_EVEN, D_MODEL, EVEN_COLS), D_MODEL),
        'mla_q_norm': gain((N_EVEN, MLA_Q_RANK)),
        'mla_w_uq': nrm((N_EVEN, MLA_Q_RANK, MLA_HEADS * (MLA_NOPE + MLA_ROPE)), MLA_Q_RANK),
        'mla_kv_norm': gain((N_EVEN, MLA_KV_RANK)),
        'mla_w_ukv': nrm((N_EVEN, MLA_KV_RANK, MLA_HEADS * (MLA_NOPE + MLA_V)), MLA_KV_RANK),
        'gla_w_gate_up': nrm((N_EVEN, GLA_GATE_RANK, GLA_HEADS * GLA_DK), GLA_GATE_RANK),
        'gla_b_gate': small((N_EVEN, GLA_HEADS * GLA_DK), 0.1),
        'gla_norm': gain((N_EVEN, GLA_DV)),
        'ag_w_out': nrm((N_EVEN, D_MODEL, D_MODEL), D_MODEL),
        'cd_w_in': nrm((N_ODD, D_MODEL, ODD_COLS), D_MODEL),
        's5_a_re': -0.5 + small((N_ODD, S5_GROUPS, S5_STATE), 0.01),
        's5_a_im': math.pi * n_idx + small((N_ODD, S5_GROUPS, S5_STATE), 0.01),
        's5_log_dt': jax.random.uniform(nk(), (N_ODD, S5_GROUPS), f32,
                                        math.log(S5_DT_MIN), math.log(S5_DT_MAX)),
        's5_b_re': nrm((N_ODD, S5_GROUPS, S5_STATE, S5_GROUP), 2 * S5_GROUP),
        's5_b_im': nrm((N_ODD, S5_GROUPS, S5_STATE, S5_GROUP), 2 * S5_GROUP),
        's5_c_re': nrm((N_ODD, S5_GROUPS, S5_GROUP, S5_STATE), S5_STATE),
        's5_c_im': nrm((N_ODD, S5_GROUPS, S5_GROUP, S5_STATE), S5_STATE),
        's5_d': jax.random.normal(nk(), (N_ODD, S5_GROUPS, S5_GROUP), f32),
        's5_w_glu': nrm((N_ODD, S5_WIDTH, S5_WIDTH), S5_WIDTH),
        's5_b_glu': small((N_ODD, S5_WIDTH), 0.01),
        'diff_lambda_q1': small((N_ODD, DIFF_DQK), 0.1),
        'diff_lambda_k1': small((N_ODD, DIFF_DQK), 0.1),
        'diff_lambda_q2': small((N_ODD, DIFF_DQK), 0.1),
        'diff_lambda_k2': small((N_ODD, DIFF_DQK), 0.1),
        'diff_norm': gain((N_ODD, DIFF_DV)),
        'cd_w_out': nrm((N_ODD, D_MODEL, D_MODEL), D_MODEL),
    }


def reference(x, positions, norm_mix, norm_ffn, final_norm, ffn_w_gate, ffn_w_up, ffn_w_down,
              ag_w_in, mla_q_norm, mla_w_uq, mla_kv_norm, mla_w_ukv, gla_w_gate_up, gla_b_gate,
              gla_norm, ag_w_out, cd_w_in, s5_a_re, s5_a_im, s5_log_dt, s5_b_re, s5_b_im,
              s5_c_re, s5_c_im, s5_d, s5_w_glu, s5_b_glu, diff_lambda_q1, diff_lambda_k1,
              diff_lambda_q2, diff_lambda_k2, diff_norm, cd_w_out):
    slopes = alibi_slopes(DIFF_HEADS)
    h = x
    for layer in range(DEPTH):
        i = layer // 2
        hn = rms_norm(h, norm_mix[layer])
        if layer % 2 == 0:
            mix = mla_gla_mixer(hn, positions, ag_w_in[i], mla_q_norm[i], mla_w_uq[i],
                                mla_kv_norm[i], mla_w_ukv[i], gla_w_gate_up[i], gla_b_gate[i],
                                gla_norm[i], ag_w_out[i])
        else:
            lambda_init = 0.8 - 0.6 * math.exp(-0.3 * layer)
            mix = s5_diff_mixer(hn, positions, slopes, lambda_init, cd_w_in[i], s5_a_re[i],
                                s5_a_im[i], s5_log_dt[i], s5_b_re[i], s5_b_im[i], s5_c_re[i],
                                s5_c_im[i], s5_d[i], s5_w_glu[i], s5_b_glu[i],
                                diff_lambda_q1[i], diff_lambda_k1[i], diff_lambda_q2[i],
                                diff_lambda_k2[i], diff_norm[i], cd_w_out[i])
        h = h + mix
        h = h + swiglu(rms_norm(h, norm_ffn[layer]), ffn_w_gate[layer], ffn_w_up[layer],
                       ffn_w_down[layer])
    return rms_norm(h, final_norm)
```

```cpp
#include <hip/hip_runtime.h>
#include <hip/hip_cooperative_groups.h>
#include <cstdio>
#include <cstdint>
#include <cmath>
namespace cg = cooperative_groups;

#define DI __device__ __forceinline__
#define LAS __attribute__((address_space(3)))
typedef unsigned short bf16_t;
typedef short bf16x8 __attribute__((ext_vector_type(8)));
typedef short s16x4 __attribute__((ext_vector_type(4)));
typedef float f32x4 __attribute__((ext_vector_type(4)));
typedef float f32x2 __attribute__((ext_vector_type(2)));
typedef float f32x16 __attribute__((ext_vector_type(16)));
typedef unsigned u32x4 __attribute__((ext_vector_type(4)));
typedef unsigned u32x2 __attribute__((ext_vector_type(2)));
typedef int i32x4 __attribute__((ext_vector_type(4)));
typedef __bf16 bf16x2_t __attribute__((ext_vector_type(2)));

#define MFMA32(a, b, c) __builtin_amdgcn_mfma_f32_32x32x16_bf16((a), (b), (c), 0, 0, 0)
#define MFMA16(a, b, c) __builtin_amdgcn_mfma_f32_16x16x32_bf16((a), (b), (c), 0, 0, 0)
#define LDS_WAIT() asm volatile("s_waitcnt lgkmcnt(0)" ::: "memory")

DI unsigned pk2(float lo, float hi) { f32x2 v = {lo, hi}; bf16x2_t b = __builtin_convertvector(v, bf16x2_t); return __builtin_bit_cast(unsigned, b); }
DI float bflo(unsigned u) { return __uint_as_float(u << 16); }
DI float bfhi(unsigned u) { return __uint_as_float(u & 0xffff0000u); }
DI float bf2f(bf16_t u) { return __uint_as_float(((unsigned)u) << 16); }
DI bf16_t f2bf(float f) { return (bf16_t)(pk2(f, 0.f) & 0xffffu); }
DI float wave_sum(float v) {
#pragma unroll
    for (int o = 1; o < 64; o <<= 1) v += __shfl_xor(v, o);
    return v;
}
DI int tid_from_wave(int wv) { int l; asm volatile("v_mbcnt_lo_u32_b32 %0, -1, 0\n\tv_mbcnt_hi_u32_b32 %0, -1, %0" : "=v"(l)); int t = wv * 64 + l; asm volatile("" : "+v"(t)); return t; }
DI float dpp_add16(float x) {
    x += __builtin_bit_cast(float, __builtin_amdgcn_update_dpp(0, __builtin_bit_cast(int, x), 0xB1, 0xF, 0xF, true));
    x += __builtin_bit_cast(float, __builtin_amdgcn_update_dpp(0, __builtin_bit_cast(int, x), 0x4E, 0xF, 0xF, true));
    x += __builtin_bit_cast(float, __builtin_amdgcn_update_dpp(0, __builtin_bit_cast(int, x), 0x141, 0xF, 0xF, true));
    x += __builtin_bit_cast(float, __builtin_amdgcn_update_dpp(0, __builtin_bit_cast(int, x), 0x140, 0xF, 0xF, true));
    return x;
}
DI int crow(int r, int hi) { return (r & 3) + 8 * (r >> 2) + 4 * hi; }
DI s16x4 tr_read(const LAS unsigned char* p) { return __builtin_bit_cast(s16x4, __builtin_amdgcn_ds_read_tr16_b64_v4i16((LAS s16x4*)p)); }
DI bf16x8 cat8(s16x4 lo, s16x4 hi) { return (bf16x8){lo[0], lo[1], lo[2], lo[3], hi[0], hi[1], hi[2], hi[3]}; }
DI float sigmoidf_(float x) { return __builtin_amdgcn_rcpf(1.f + __expf(-x)); }
DI float siluf_(float x) { return x * __builtin_amdgcn_rcpf(1.f + __expf(-x)); }

constexpr int NTOK = 16384, SEQ = 2048, NBATCH = 8, DM = 2048, FFH = 5632;
constexpr int PROJ_LD = 4096, SMALL_LD = 128, Q_LD = 1536, KV_LD = 2048;
constexpr int NIN0 = 4352;
constexpr float RMS_EPS = 1e-6f;
constexpr float LOG2E = 1.4426950408889634f;
constexpr float LAMBDA_INIT = 0.35550906759f;

constexpr size_t WS_CTL = 0;
constexpr size_t WS_WIN0 = 1048576;
constexpr size_t WS_SS = 65536;
constexpr size_t WS_WUQ = WS_WIN0 + (size_t)NIN0 * 2048 * 2;
constexpr size_t WS_WUKV = WS_WUQ + (size_t)1536 * 512 * 2;
constexpr size_t WS_WOUT0 = WS_WUKV + (size_t)2048 * 512 * 2;
constexpr size_t WS_WGU0 = WS_WOUT0 + (size_t)2048 * 2048 * 2;
constexpr size_t WS_WDN0 = WS_WGU0 + (size_t)11264 * 2048 * 2;
constexpr size_t WS_WIN1 = WS_WDN0 + (size_t)2048 * 5632 * 2;
constexpr size_t WS_WGLU = WS_WIN1 + (size_t)4096 * 2048 * 2;
constexpr size_t WS_WOUT1 = WS_WGLU + (size_t)1024 * 1024 * 2;
constexpr size_t WS_WGU1 = WS_WOUT1 + (size_t)2048 * 2048 * 2;
constexpr size_t WS_WDN1 = WS_WGU1 + (size_t)11264 * 2048 * 2;
constexpr size_t WS_HN = WS_WDN1 + (size_t)2048 * 5632 * 2;
constexpr size_t WS_PROJ = WS_HN + (size_t)NTOK * 2048 * 2;
constexpr size_t WS_SMALL = WS_PROJ + (size_t)NTOK * 4096 * 2;
constexpr size_t WS_Q = WS_SMALL + (size_t)NTOK * 128 * 2;
constexpr size_t WS_KV = WS_Q + (size_t)NTOK * 1536 * 2;
constexpr size_t WS_END = WS_KV + (size_t)NTOK * 2048 * 2;
constexpr size_t WS_ACT = WS_PROJ;
static_assert(WS_ACT + (size_t)NTOK * FFH * 2 <= WS_END, "ACT overlay");
static_assert(WS_END <= (size_t)512 * 1024 * 1024, "workspace");

constexpr int LDS_RING = 131072, MISC_OFF = LDS_RING, LDS_BYTES = LDS_RING + 1024;

namespace pg8 {
constexpr int BM = 256, BK = 64, HALF = 128, HTB = HALF * BK * 2, NXCD = 8, WGM = 4;
DI int lds_byte(int r, int c) { const int st = (r >> 4) * 2 + (c >> 5), rr = r & 15, cc = c & 31, ob = rr * 64 + cc * 2; return st * 1024 + (ob ^ (((ob >> 9) & 1) << 5)); }
DI void stage_rc(int b, int& R, int& C) { const int st = b / 1024, sb = b % 1024, swz = sb ^ (((sb >> 9) & 1) << 5); R = (st >> 1) * 16 + swz / 64; C = (st & 1) * 32 + (swz % 64) / 2; }
DI int perm32(int rho) { const int n = rho >> 4, i = rho & 15; return 8 * (i >> 2) + 4 * n + (i & 3); }

struct Unit { int pm, pn; };
struct Gemm { const bf16_t* A; const bf16_t* Bt; int M, N, K, lda; };

struct StaticOrder {
    int nM, nN, nwg, G, c;
    DI void init(int M, int N, int G_, int c_) { nM = M / BM; nN = N / BM; nwg = nM * nN; G = G_; c = c_; }
    DI bool next(int i, Unit& u) const {
        const long L = (long)i * G + c; if (L >= nwg) return false;
        int wgid = (int)L; { const int q = nwg / NXCD, r = nwg % NXCD, xcd = wgid % NXCD, off = wgid / NXCD; wgid = (xcd < r ? xcd * (q + 1) : r * (q + 1) + (xcd - r) * q) + off; }
        const int nig = WGM * nN, gid = wgid / nig, fm = gid * WGM, gsz = (nM - fm) < WGM ? (nM - fm) : WGM;
        u.pm = fm + ((wgid % nig) % gsz); u.pn = (wgid % nig) / gsz; return true;
    }
};


struct EpiBf16 {
    static constexpr bool PERM = true;
    bf16_t* O; int ldc; int split_pn; bf16_t* O2; int ld2; const float* ss;
    DI void operator()(const f32x4 (&acc)[2][2][4][2], const Unit& u, int wr, int wc, int fr, int fq) const {
        const int row0 = u.pm * BM + wr * 64 + fr;
        const bool sp = u.pn >= split_pn;
        bf16_t* base = sp ? O2 : O; const int ld = sp ? ld2 : ldc;
        const int col0 = (sp ? 0 : u.pn * BM) + wc * 32 + 8 * fq;
        float rsv[8];
#pragma unroll
        for (int q = 0; q < 8; ++q) rsv[q] = ss ? ss[row0 + (q >> 2) * HALF + (q & 3) * 16] : 0.f;
#pragma unroll
        for (int q = 0; q < 8; ++q) rsv[q] = ss ? 1.f / sqrtf(rsv[q] * (1.f / DM) + RMS_EPS) : 1.f;
#pragma unroll
        for (int ai = 0; ai < 2; ++ai)
#pragma unroll
            for (int m = 0; m < 4; ++m) { const int row = row0 + ai * HALF + m * 16; bf16_t* rowp = base + (size_t)row * ld + col0;
                const float rs = rsv[ai * 4 + m];
#pragma unroll
                for (int bj = 0; bj < 2; ++bj) { if (sp && bj == 1) continue;
                    const f32x4 v0 = acc[ai][bj][m][0] * rs, v1 = acc[ai][bj][m][1] * rs;
                    u32x4 w; w.x = pk2(v0[0], v0[1]); w.y = pk2(v0[2], v0[3]); w.z = pk2(v1[0], v1[1]); w.w = pk2(v1[2], v1[3]);
                    *(u32x4*)(rowp + bj * HALF) = w; } }
    }
};
struct EpiNone { static constexpr bool PERM = true; DI void operator()(const f32x4 (&acc)[2][2][4][2], const Unit& u, int wr, int wc, int fr, int fq) const { float t = 0.f;
#pragma unroll
    for (int a = 0; a < 2; ++a) for (int b = 0; b < 2; ++b) for (int m = 0; m < 4; ++m) for (int n = 0; n < 2; ++n) t += acc[a][b][m][n][0];
    asm volatile("" :: "v"(t)); } };
struct EpiResF32 {
    static constexpr bool PERM = false;
    const float* base; float* out; int ldc; bf16_t* hb; float* ss;
    DI void operator()(const f32x4 (&acc)[2][2][4][2], const Unit& u, int wr, int wc, int fr, int fq) const {
        const int col0 = u.pn * BM + wc * 32 + 4 * fq;
#pragma unroll
        for (int ai = 0; ai < 2; ++ai) {
            f32x4 pre[4][2][2];
#pragma unroll
            for (int m = 0; m < 4; ++m) { const size_t off = (size_t)(u.pm * BM + ai * HALF + wr * 64 + m * 16 + fr) * ldc + col0;
#pragma unroll
                for (int bj = 0; bj < 2; ++bj)
#pragma unroll
                    for (int n = 0; n < 2; ++n) pre[m][bj][n] = *(const f32x4*)(base + off + bj * HALF + n * 16); }
            asm volatile("" ::: "memory");
#pragma unroll
            for (int m = 0; m < 4; ++m) { const int row = u.pm * BM + ai * HALF + wr * 64 + m * 16 + fr; const size_t off = (size_t)row * ldc + col0;
                float sq = 0.f;
#pragma unroll
                for (int bj = 0; bj < 2; ++bj)
#pragma unroll
                    for (int n = 0; n < 2; ++n) { const f32x4 bs = pre[m][bj][n]; const f32x4 v = bs + acc[ai][bj][m][n];
                        *(f32x4*)(out + off + bj * HALF + n * 16) = v;
                        if (ss) sq += (v.x * v.x + v.y * v.y) + (v.z * v.z + v.w * v.w);
                        if (hb) { u32x2 w; w.x = pk2(v.x, v.y); w.y = pk2(v.z, v.w); *(u32x2*)(hb + off + bj * HALF + n * 16) = w; } }
                if (ss) { sq += __shfl_xor(sq, 16); sq += __shfl_xor(sq, 32); if (fq == 0) atomicAdd(ss + row, sq); } }
        }
    }
};
struct EpiResNormOut {
    static constexpr bool PERM = false;
    const float* base; float* out; int ldc; float* ss; unsigned* cnt; const float* g;
    DI void operator()(f32x4 (&acc)[2][2][4][2], const Unit& u, int wr, int wc, int fr, int fq) const {
        const int col0 = u.pn * BM + wc * 32 + 4 * fq;
#pragma unroll
        for (int ai = 0; ai < 2; ++ai) {
            f32x4 pre[4][2][2];
#pragma unroll
            for (int m = 0; m < 4; ++m) { const size_t off = (size_t)(u.pm * BM + ai * HALF + wr * 64 + m * 16 + fr) * ldc + col0;
#pragma unroll
                for (int bj = 0; bj < 2; ++bj)
#pragma unroll
                    for (int n = 0; n < 2; ++n) pre[m][bj][n] = *(const f32x4*)(base + off + bj * HALF + n * 16); }
            asm volatile("" ::: "memory");
#pragma unroll
            for (int m = 0; m < 4; ++m) { const int row = u.pm * BM + ai * HALF + wr * 64 + m * 16 + fr;
                float sq = 0.f;
#pragma unroll
                for (int bj = 0; bj < 2; ++bj)
#pragma unroll
                    for (int n = 0; n < 2; ++n) { const f32x4 v = pre[m][bj][n] + acc[ai][bj][m][n]; acc[ai][bj][m][n] = v; sq += (v.x * v.x + v.y * v.y) + (v.z * v.z + v.w * v.w); }
                sq += __shfl_xor(sq, 16); sq += __shfl_xor(sq, 32); if (fq == 0) atomicAdd(ss + row, sq); }
        }
        __builtin_amdgcn_fence(__ATOMIC_RELEASE, "agent");
        asm volatile("s_waitcnt vmcnt(0)" ::: "memory");
        unsigned* cw = cnt + 32 * u.pm;
        if (fr == 0 && fq == 0) __hip_atomic_fetch_add(cw, 1u, __ATOMIC_RELAXED, __HIP_MEMORY_SCOPE_AGENT);
        { unsigned sp = 0; while ((unsigned)__builtin_amdgcn_readfirstlane((int)__hip_atomic_load(cw, __ATOMIC_RELAXED, __HIP_MEMORY_SCOPE_AGENT)) < 64u) { __builtin_amdgcn_s_sleep(2); if (++sp > (1u << 20)) break; } }
        __builtin_amdgcn_fence(__ATOMIC_ACQUIRE, "agent");
        f32x4 gv[2][2];
#pragma unroll
        for (int bj = 0; bj < 2; ++bj)
#pragma unroll
            for (int n = 0; n < 2; ++n) gv[bj][n] = *(const f32x4*)(g + col0 + bj * HALF + n * 16);
#pragma unroll
        for (int ai = 0; ai < 2; ++ai)
#pragma unroll
            for (int m = 0; m < 4; ++m) { const int row = u.pm * BM + ai * HALF + wr * 64 + m * 16 + fr; const size_t off = (size_t)row * ldc + col0;
                const float rs = 1.f / sqrtf(__hip_atomic_load(ss + row, __ATOMIC_RELAXED, __HIP_MEMORY_SCOPE_AGENT) * (1.f / DM) + RMS_EPS);
#pragma unroll
                for (int bj = 0; bj < 2; ++bj)
#pragma unroll
                    for (int n = 0; n < 2; ++n) *(f32x4*)(out + off + bj * HALF + n * 16) = acc[ai][bj][m][n] * rs * gv[bj][n]; }
    }
};
struct EpiSwiGLU {
    static constexpr bool PERM = true;
    bf16_t* O; int ldc; const float* ss;
    DI void operator()(const f32x4 (&acc)[2][2][4][2], const Unit& u, int wr, int wc, int fr, int fq) const {
        const int row0 = u.pm * BM + wr * 64 + fr, col0 = u.pn * HALF + wc * 32 + 8 * fq;
        float rsv[8];
#pragma unroll
        for (int q = 0; q < 8; ++q) rsv[q] = ss[row0 + (q >> 2) * HALF + (q & 3) * 16];
#pragma unroll
        for (int q = 0; q < 8; ++q) rsv[q] = 1.f / sqrtf(rsv[q] * (1.f / DM) + RMS_EPS);
#pragma unroll
        for (int ai = 0; ai < 2; ++ai)
#pragma unroll
            for (int m = 0; m < 4; ++m) { const int row = row0 + ai * HALF + m * 16; bf16_t* rowp = O + (size_t)row * ldc + col0;
                const float rs = rsv[ai * 4 + m];
                float r[8];
#pragma unroll
                for (int n = 0; n < 2; ++n)
#pragma unroll
                    for (int j = 0; j < 4; ++j) { const float g = acc[ai][0][m][n][j] * rs, up = acc[ai][1][m][n][j] * rs; r[n * 4 + j] = siluf_(g) * up; }
                u32x4 w; w.x = pk2(r[0], r[1]); w.y = pk2(r[2], r[3]); w.z = pk2(r[4], r[5]); w.w = pk2(r[6], r[7]);
                *(u32x4*)rowp = w; }
    }
};
struct EpiGLU {
    static constexpr bool PERM = true;
    const bf16_t* Z; int ldz; const float* bias; bf16_t* O; int ldc;
    DI void operator()(const f32x4 (&acc)[2][2][4][2], const Unit& u, int wr, int wc, int fr, int fq) const {
        const int row0 = u.pm * BM + wr * 64 + fr, col0 = u.pn * BM + wc * 32 + 8 * fq;
#pragma unroll
        for (int bj = 0; bj < 2; ++bj) {
            const f32x4 b0 = *(const f32x4*)(bias + col0 + bj * HALF), b1 = *(const f32x4*)(bias + col0 + bj * HALF + 4);
#pragma unroll
            for (int ai = 0; ai < 2; ++ai)
#pragma unroll
                for (int m = 0; m < 4; ++m) { const size_t r = (size_t)(row0 + ai * HALF + m * 16);
                    const u32x4 zz = *(const u32x4*)(Z + r * ldz + col0 + bj * HALF);
                    const f32x4 v0 = acc[ai][bj][m][0] + b0, v1 = acc[ai][bj][m][1] + b1;
                    u32x4 w;
                    w.x = pk2(bflo(zz.x) * sigmoidf_(v0[0]), bfhi(zz.x) * sigmoidf_(v0[1]));
                    w.y = pk2(bflo(zz.y) * sigmoidf_(v0[2]), bfhi(zz.y) * sigmoidf_(v0[3]));
                    w.z = pk2(bflo(zz.z) * sigmoidf_(v1[0]), bfhi(zz.z) * sigmoidf_(v1[1]));
                    w.w = pk2(bflo(zz.w) * sigmoidf_(v1[2]), bfhi(zz.w) * sigmoidf_(v1[3]));
                    *(u32x4*)(O + r * ldc + col0 + bj * HALF) = w; }
        }
    }
};

#ifndef GEMM_SP2
#define GEMM_SP2 true
#endif
template <class Epi, bool SP2 = GEMM_SP2>
DI void gemm_phase(LAS unsigned char* lds, const Gemm g, const StaticOrder& S, const Epi& E, int wv) {
    const int tid_ = tid_from_wave(wv);
    const int tid = tid_, wid = __builtin_amdgcn_readfirstlane(tid >> 6), lane = tid & 63, wr = wid >> 2, wc = wid & 3, fr = lane & 15, fq = lane >> 4;
    const int K = g.K, nt = K / BK, lda = g.lda;
    unsigned voffA[2], voffB[2];
#pragma unroll
    for (int i = 0; i < 2; ++i) { int R, C; stage_rc(tid * 16 + i * 8192, R, C); const int Rb = Epi::PERM ? ((R & ~31) + perm32(R & 31)) : R;
        voffA[i] = (unsigned)(R * lda + C) * 2u; voffB[i] = (unsigned)(Rb * K + C) * 2u; }
    const size_t kstep = (size_t)(BK * 2);
    const size_t hstepA = (size_t)HALF * lda * 2, hstepB = (size_t)HALF * K * 2;
    const size_t tstepA = 2 * hstepA, tstepB = 2 * hstepB;
    const unsigned ldsw = (unsigned)wid * 1024u;
    const int aoff = lds_byte(wr * 64 + fr, fq * 8), boff = lds_byte(wc * 32 + fr, fq * 8);
#define PG8_SA(b, h) (((b) * 2 + (h)) * HTB)
#define PG8_SB(b, h) ((4 + (b) * 2 + (h)) * HTB)
#define PG8_STAGE(bufoff, gbase, voff) do { _Pragma("unroll") for (int _i = 0; _i < 2; ++_i) \
        __builtin_amdgcn_global_load_lds((const unsigned*)((const char*)(gbase) + (voff)[_i]), (LAS unsigned*)(lds + (bufoff) + ldsw + _i * 8192), 16, 0, 0); } while (0)
#define PG8_LDA(dst, b, h) do { _Pragma("unroll") for (int m = 0; m < 4; ++m) _Pragma("unroll") for (int k = 0; k < 2; ++k) dst[m][k] = *(const LAS bf16x8*)(lds + PG8_SA(b, h) + aoff + m * 2048 + k * 1024); } while (0)
#define PG8_LDB(dst, b, h) do { _Pragma("unroll") for (int n = 0; n < 2; ++n) _Pragma("unroll") for (int k = 0; k < 2; ++k) dst[n][k] = *(const LAS bf16x8*)(lds + PG8_SB(b, h) + boff + n * 2048 + k * 1024); } while (0)
#define PG8_MMA(ai, bj, At, Bt) do { __builtin_amdgcn_s_setprio(1); _Pragma("unroll") for (int m = 0; m < 4; ++m) _Pragma("unroll") for (int n = 0; n < 2; ++n) _Pragma("unroll") for (int k = 0; k < 2; ++k) \
        acc[ai][bj][m][n] = __builtin_amdgcn_mfma_f32_16x16x32_bf16(Bt[n][k], At[m][k], acc[ai][bj][m][n], 0, 0, 0); __builtin_amdgcn_s_setprio(0); } while (0)
#define PG8_WAIT_V(n) asm volatile("s_waitcnt vmcnt(" #n ")" ::: "memory")
#define PG8_WAIT_L(n) asm volatile("s_waitcnt lgkmcnt(" #n ")" ::: "memory")
#define PG8_BAR __builtin_amdgcn_s_barrier()
#define PG8_SCHED __builtin_amdgcn_sched_barrier(0)
    Unit cur, nxt; int ui = 0;
    if (!S.next(0, cur)) return;
    f32x4 acc[2][2][4][2];
#pragma unroll
    for (int a = 0; a < 2; ++a)
#pragma unroll
        for (int b = 0; b < 2; ++b)
#pragma unroll
            for (int m = 0; m < 4; ++m)
#pragma unroll
                for (int n = 0; n < 2; ++n) acc[a][b][m][n] = (f32x4){0.f, 0.f, 0.f, 0.f};
    bf16x8 At[4][2], B0[2][2], B1[2][2];
    const char* cA = (const char*)g.A + (size_t)cur.pm * tstepA; const char* cB = (const char*)g.Bt + (size_t)cur.pn * tstepB;
    if constexpr (SP2) {
    PG8_STAGE(PG8_SB(0, 0), cB, voffB); PG8_STAGE(PG8_SB(0, 1), cB + hstepB, voffB); PG8_STAGE(PG8_SA(0, 0), cA, voffA); PG8_STAGE(PG8_SA(0, 1), cA + hstepA, voffA);
    if (wr == 1) PG8_BAR;
    PG8_WAIT_V(2); PG8_BAR;
    PG8_STAGE(PG8_SB(1, 0), cB + kstep, voffB); PG8_STAGE(PG8_SA(1, 0), cA + kstep, voffA); PG8_STAGE(PG8_SB(1, 1), cB + hstepB + kstep, voffB);
    PG8_WAIT_V(6); PG8_BAR;
    } else {
    PG8_STAGE(PG8_SB(0, 0), cB, voffB); PG8_STAGE(PG8_SA(0, 0), cA, voffA); PG8_STAGE(PG8_SB(0, 1), cB + hstepB, voffB); PG8_STAGE(PG8_SA(0, 1), cA + hstepA, voffA);
    if (wr == 1) PG8_BAR;
    PG8_WAIT_V(4); PG8_BAR;
    PG8_STAGE(PG8_SB(1, 0), cB + kstep, voffB); PG8_STAGE(PG8_SA(1, 0), cA + kstep, voffA); PG8_STAGE(PG8_SB(1, 1), cB + hstepB + kstep, voffB);
    PG8_WAIT_V(6); PG8_BAR;
    }
    for (;;) {
        const bool has_next = S.next(ui + 1, nxt);
        const char* nA = has_next ? (const char*)g.A + (size_t)nxt.pm * tstepA : cA; const char* nB = has_next ? (const char*)g.Bt + (size_t)nxt.pn * tstepB : cB;
        for (int t = 0; t < nt; t += 2) {
            const bool last = (t == nt - 2);
            const char* a1 = cA + (size_t)(t + 1) * kstep;
            const char* a2 = last ? nA : cA + (size_t)(t + 2) * kstep; const char* b2 = last ? nB : cB + (size_t)(t + 2) * kstep;
            const char* a3 = a2 + kstep; const char* b3 = b2 + kstep;
            if constexpr (!SP2) {
            PG8_LDB(B0, 0, 0); PG8_SCHED; PG8_LDA(At, 0, 0); PG8_STAGE(PG8_SA(1, 1), a1 + hstepA, voffA);
            PG8_WAIT_L(8); PG8_BAR; PG8_WAIT_L(0); PG8_MMA(0, 0, At, B0); PG8_BAR; PG8_SCHED;
            PG8_LDB(B1, 0, 1); PG8_STAGE(PG8_SB(0, 0), b2, voffB);
            PG8_BAR; PG8_WAIT_L(0); PG8_MMA(0, 1, At, B1); PG8_BAR;
            PG8_LDA(At, 0, 1); PG8_STAGE(PG8_SA(0, 0), a2, voffA);
            PG8_BAR; PG8_WAIT_L(0); PG8_MMA(1, 0, At, B0); PG8_BAR; PG8_SCHED;
            PG8_STAGE(PG8_SB(0, 1), b2 + hstepB, voffB);
            PG8_WAIT_V(6); PG8_BAR; PG8_MMA(1, 1, At, B1); PG8_BAR;
            PG8_LDB(B0, 1, 0); PG8_SCHED; PG8_LDA(At, 1, 0); PG8_STAGE(PG8_SA(0, 1), a2 + hstepA, voffA);
            PG8_WAIT_L(8); PG8_BAR; PG8_WAIT_L(0); PG8_MMA(0, 0, At, B0); PG8_BAR; PG8_SCHED;
            PG8_LDB(B1, 1, 1); PG8_STAGE(PG8_SB(1, 0), b3, voffB);
            PG8_BAR; PG8_WAIT_L(0); PG8_MMA(0, 1, At, B1); PG8_BAR;
            PG8_LDA(At, 1, 1); PG8_STAGE(PG8_SA(1, 0), a3, voffA);
            PG8_BAR; PG8_WAIT_L(0); PG8_MMA(1, 0, At, B0); PG8_BAR; PG8_SCHED;
            PG8_STAGE(PG8_SB(1, 1), b3 + hstepB, voffB);
            PG8_WAIT_V(6); PG8_BAR; PG8_MMA(1, 1, At, B1); PG8_BAR;
            } else {
            PG8_LDB(B0, 0, 0); PG8_LDB(B1, 0, 1); PG8_SCHED; PG8_LDA(At, 0, 0); PG8_STAGE(PG8_SA(1, 1), a1 + hstepA, voffA);
            PG8_WAIT_V(8); PG8_WAIT_L(0); PG8_BAR; PG8_MMA(0, 0, At, B0); PG8_MMA(0, 1, At, B1); PG8_BAR; PG8_SCHED;
            PG8_LDA(At, 0, 1); PG8_STAGE(PG8_SB(0, 0), b2, voffB); PG8_STAGE(PG8_SB(0, 1), b2 + hstepB, voffB); PG8_STAGE(PG8_SA(0, 0), a2, voffA);
            PG8_WAIT_V(8); PG8_WAIT_L(0); PG8_BAR; PG8_MMA(1, 0, At, B0); PG8_MMA(1, 1, At, B1); PG8_BAR; PG8_SCHED;
            PG8_LDB(B0, 1, 0); PG8_LDB(B1, 1, 1); PG8_SCHED; PG8_LDA(At, 1, 0); PG8_STAGE(PG8_SA(0, 1), a2 + hstepA, voffA);
            PG8_WAIT_V(8); PG8_WAIT_L(0); PG8_BAR; PG8_MMA(0, 0, At, B0); PG8_MMA(0, 1, At, B1); PG8_BAR; PG8_SCHED;
            PG8_LDA(At, 1, 1); PG8_STAGE(PG8_SB(1, 0), b3, voffB); PG8_STAGE(PG8_SB(1, 1), b3 + hstepB, voffB); PG8_STAGE(PG8_SA(1, 0), a3, voffA);
            PG8_WAIT_V(8); PG8_WAIT_L(0); PG8_BAR; PG8_MMA(1, 0, At, B0); PG8_MMA(1, 1, At, B1); PG8_BAR; PG8_SCHED;
            }
        }
        if (wr == 0) PG8_BAR;
        E(acc, cur, wr, wc, fr, fq);
        if (!has_next) break;
#pragma unroll
        for (int a = 0; a < 2; ++a)
#pragma unroll
            for (int b = 0; b < 2; ++b)
#pragma unroll
                for (int m = 0; m < 4; ++m)
#pragma unroll
                    for (int n = 0; n < 2; ++n) acc[a][b][m][n] = (f32x4){0.f, 0.f, 0.f, 0.f};
        cur = nxt; cA = nA; cB = nB; ++ui;
        if (wr == 1) PG8_BAR;
    }
    PG8_WAIT_V(0);
    PG8_BAR;
#undef PG8_SA
#undef PG8_SB
#undef PG8_STAGE
#undef PG8_LDA
#undef PG8_LDB
#undef PG8_MMA
#undef PG8_WAIT_V
#undef PG8_WAIT_L
#undef PG8_BAR
#undef PG8_SCHED
}
}

struct Params {
    const float* in[34];
    float* out;
    unsigned char* ws;
};

DI int rowmap(int mode, int n) {
    if (mode == 0) return n;
    if (mode == 1) {
        if (n < 1024) return n;
        if (n < 1088) return 4096 + (n - 1024);
        if (n < 2112) return 1024 + (n - 1088);
        if (n < 3136) return 2048 + (n - 2112);
        if (n < 3152) return 4096 + 64 + (n - 3136);
        return 3072 + (n - 3152);
    }
    if (mode == 2) return (n >> 7) * 256 + (n & 127);
    return (n >> 7) * 256 + 128 + (n & 127);
}
DI void transpose_item(const float* __restrict__ W, int K, int N, bf16_t* WT, int mode, LAS float* scr, int item, int lane, const float* kscale = nullptr) {
    const int nblk = (N + 31) >> 5, kb = item / nblk, nb = item - kb * nblk, k0 = 64 * kb, n0 = 32 * nb;
    const int r8 = lane >> 3, c4 = (lane & 7) * 4;
    const bool okl = n0 + c4 < N;
    f32x4 v[8];
    const float* src = W + (size_t)(k0 + r8) * N + n0 + c4;
#pragma unroll
    for (int i = 0; i < 8; ++i) v[i] = okl ? *(const f32x4*)(src + (size_t)(8 * i) * N) : (f32x4){0.f, 0.f, 0.f, 0.f};
    if (kscale) {
#pragma unroll
        for (int i = 0; i < 8; ++i) v[i] = v[i] * kscale[k0 + r8 + 8 * i];
    }
#pragma unroll
    for (int i = 0; i < 8; ++i) { LAS float* d = scr + (r8 + 8 * i) * 33 + c4; d[0] = v[i].x; d[1] = v[i].y; d[2] = v[i].z; d[3] = v[i].w; }
    LDS_WAIT();
    const int c = lane & 7;
#pragma unroll
    for (int j = 0; j < 4; ++j) { const int n = (lane >> 3) + 8 * j; const LAS float* s = scr + (8 * c) * 33 + n;
        u32x4 o; o.x = pk2(s[0 * 33], s[1 * 33]); o.y = pk2(s[2 * 33], s[3 * 33]); o.z = pk2(s[4 * 33], s[5 * 33]); o.w = pk2(s[6 * 33], s[7 * 33]);
        if (n0 + n < N) *(u32x4*)(WT + (size_t)rowmap(mode, n0 + n) * K + k0 + 8 * c) = o; }
    LDS_WAIT();
}
DI void rms_row_bf16(const float* xrow, const float* g, bf16_t* orow, int lane) {
    const f32x4* xr = (const f32x4*)xrow + lane; const f32x4* gr = (const f32x4*)g + lane;
    f32x4 v[8]; float s = 0.f;
#pragma unroll
    for (int j = 0; j < 8; ++j) { v[j] = xr[64 * j]; s += (v[j].x * v[j].x + v[j].y * v[j].y) + (v[j].z * v[j].z + v[j].w * v[j].w); }
    const float rstd = 1.f / sqrtf(wave_sum(s) * (1.f / DM) + RMS_EPS);
    u32x2* o8 = (u32x2*)orow + lane;
#pragma unroll
    for (int j = 0; j < 8; ++j) { const f32x4 gg = gr[64 * j]; u32x2 w; w.x = pk2(v[j].x * rstd * gg.x, v[j].y * rstd * gg.y); w.y = pk2(v[j].z * rstd * gg.z, v[j].w * rstd * gg.w); o8[64 * j] = w; }
}
DI void rms_rows_phase(const float* src, const float* g, bf16_t* dst, int gw, int ngw, int lane) {
    const f32x4* gr = (const f32x4*)g + lane;
    for (int m = gw; m < NTOK; m += 2 * ngw) {
        const int m2 = (m + ngw < NTOK) ? m + ngw : m;
        const f32x4* xa = (const f32x4*)(src + (size_t)m * DM) + lane; const f32x4* xb = (const f32x4*)(src + (size_t)m2 * DM) + lane;
        f32x4 va[8], vb[8]; float sa = 0.f, sb = 0.f;
#pragma unroll
        for (int j = 0; j < 8; ++j) va[j] = xa[64 * j];
#pragma unroll
        for (int j = 0; j < 8; ++j) vb[j] = xb[64 * j];
#pragma unroll
        for (int j = 0; j < 8; ++j) { sa += (va[j].x * va[j].x + va[j].y * va[j].y) + (va[j].z * va[j].z + va[j].w * va[j].w); sb += (vb[j].x * vb[j].x + vb[j].y * vb[j].y) + (vb[j].z * vb[j].z + vb[j].w * vb[j].w); }
        const float ra = 1.f / sqrtf(wave_sum(sa) * (1.f / DM) + RMS_EPS), rb = 1.f / sqrtf(wave_sum(sb) * (1.f / DM) + RMS_EPS);
        u32x2* oa = (u32x2*)(dst + (size_t)m * DM) + lane; u32x2* ob = (u32x2*)(dst + (size_t)m2 * DM) + lane;
#pragma unroll
        for (int j = 0; j < 8; ++j) { const f32x4 gg = gr[64 * j]; u32x2 w;
            w.x = pk2(va[j].x * ra * gg.x, va[j].y * ra * gg.y); w.y = pk2(va[j].z * ra * gg.z, va[j].w * ra * gg.w); oa[64 * j] = w;
            w.x = pk2(vb[j].x * rb * gg.x, vb[j].y * rb * gg.y); w.y = pk2(vb[j].z * rb * gg.z, vb[j].w * rb * gg.w); ob[64 * j] = w; }
    }
}
DI void final_norm_phase(float* h, const float* g, const float* ss, int gw, int ngw, int lane) {
    const f32x4* gr = (const f32x4*)g + lane;
    for (int m = gw; m < NTOK; m += 2 * ngw) {
        const int m2 = m + ngw; const bool has2 = m2 < NTOK;
        f32x4* xa = (f32x4*)(h + (size_t)m * DM) + lane; f32x4* xb = (f32x4*)(h + (size_t)(has2 ? m2 : m) * DM) + lane;
        f32x4 va[8], vb[8];
#pragma unroll
        for (int j = 0; j < 8; ++j) va[j] = xa[64 * j];
#pragma unroll
        for (int j = 0; j < 8; ++j) vb[j] = xb[64 * j];
        const float ra = 1.f / sqrtf(ss[m] * (1.f / DM) + RMS_EPS), rb = 1.f / sqrtf(ss[has2 ? m2 : m] * (1.f / DM) + RMS_EPS);
#pragma unroll
        for (int j = 0; j < 8; ++j) { const f32x4 gg = gr[64 * j]; xa[64 * j] = va[j] * ra * gg; if (has2) xb[64 * j] = vb[j] * rb * gg; }
    }
}

DI void p0_prologue(const Params& P, LAS unsigned char* lds, int gw, int ngw, int wave, int lane) {
    LAS float* scr = (LAS float*)(lds + wave * 16384);
    unsigned char* ws = P.ws;
    constexpr int I_IN0 = 32 * 131, I_UQ = 8 * 48, I_UKV = 8 * 64, I_OUT = 32 * 64, I_GU = 32 * 176, I_DN = 88 * 64, I_IN1 = 32 * 128, I_GLU = 16 * 32;
    constexpr int NITEMS = I_IN0 + I_UQ + I_UKV + 2 * I_OUT + 4 * I_GU + 2 * I_DN + I_IN1 + I_GLU;
    constexpr size_t FW = (size_t)DM * FFH;
    for (int it = gw; it < NITEMS; it += ngw) {
        int r = it;
        if (r < I_GU) { transpose_item(P.in[5], DM, FFH, (bf16_t*)(ws + WS_WGU0), 2, scr, r, lane, P.in[3]); continue; } r -= I_GU;
        if (r < I_GU) { transpose_item(P.in[6], DM, FFH, (bf16_t*)(ws + WS_WGU0), 3, scr, r, lane, P.in[3]); continue; } r -= I_GU;
        if (r < I_DN) { transpose_item(P.in[7], FFH, DM, (bf16_t*)(ws + WS_WDN0), 0, scr, r, lane); continue; } r -= I_DN;
        if (r < I_GU) { transpose_item(P.in[5] + FW, DM, FFH, (bf16_t*)(ws + WS_WGU1), 2, scr, r, lane, P.in[3] + DM); continue; } r -= I_GU;
        if (r < I_GU) { transpose_item(P.in[6] + FW, DM, FFH, (bf16_t*)(ws + WS_WGU1), 3, scr, r, lane, P.in[3] + DM); continue; } r -= I_GU;
        if (r < I_DN) { transpose_item(P.in[7] + FW, FFH, DM, (bf16_t*)(ws + WS_WDN1), 0, scr, r, lane); continue; } r -= I_DN;
        if (r < I_IN0) { transpose_item(P.in[8], DM, 4176, (bf16_t*)(ws + WS_WIN0), 1, scr, r, lane); continue; } r -= I_IN0;
        if (r < I_UQ) { transpose_item(P.in[10], 512, 1536, (bf16_t*)(ws + WS_WUQ), 0, scr, r, lane); continue; } r -= I_UQ;
        if (r < I_UKV) { transpose_item(P.in[12], 512, 2048, (bf16_t*)(ws + WS_WUKV), 0, scr, r, lane); continue; } r -= I_UKV;
        if (r < I_OUT) { transpose_item(P.in[16], DM, DM, (bf16_t*)(ws + WS_WOUT0), 0, scr, r, lane); continue; } r -= I_OUT;
        if (r < I_IN1) { transpose_item(P.in[17], DM, 4096, (bf16_t*)(ws + WS_WIN1), 0, scr, r, lane, P.in[2] + DM); continue; } r -= I_IN1;
        if (r < I_GLU) { transpose_item(P.in[26], 1024, 1024, (bf16_t*)(ws + WS_WGLU), 0, scr, r, lane); continue; } r -= I_GLU;
        transpose_item(P.in[33], DM, DM, (bf16_t*)(ws + WS_WOUT1), 0, scr, r, lane);
    }
    { u32x4* z = (u32x4*)(ws + WS_WIN0 + (size_t)(4096 + 80) * 2048 * 2); const int n16 = (NIN0 - 4096 - 80) * 2048 * 2 / 16;
      for (int i = gw * 64 + lane; i < n16; i += ngw * 64) z[i] = (u32x4){0u, 0u, 0u, 0u}; }
    { float* ssz = (float*)(ws + WS_SS); for (int i = gw * 64 + lane; i < 4 * NTOK; i += ngw * 64) ssz[i] = 0.f; }
    rms_rows_phase(P.in[0], P.in[2], (bf16_t*)(ws + WS_HN), gw, ngw, lane);
}

DI void p2_rowpass(const Params& P, int gw, int ngw, int lane) {
    bf16_t* proj = (bf16_t*)(P.ws + WS_PROJ); bf16_t* small = (bf16_t*)(P.ws + WS_SMALL);
    const int* pos = (const int*)P.in[1];
    for (int m = gw; m < NTOK; m += ngw) {
#pragma unroll
        for (int part = 0; part < 2; ++part) {
            u32x4* p = (u32x4*)(proj + (size_t)m * PROJ_LD + part * 512) + lane;
            const u32x4 w = *p; float f[8] = {bflo(w.x), bfhi(w.x), bflo(w.y), bfhi(w.y), bflo(w.z), bfhi(w.z), bflo(w.w), bfhi(w.w)};
            float s = 0.f;
#pragma unroll
            for (int j = 0; j < 8; ++j) s += f[j] * f[j];
            const float rstd = 1.f / sqrtf(wave_sum(s) * (1.f / 512.f) + RMS_EPS);
            const float* g = (part == 0 ? P.in[9] : P.in[11]) + lane * 8;
            const f32x4 g0 = *(const f32x4*)g, g1 = *(const f32x4*)(g + 4);
            u32x4 o; o.x = pk2(f[0] * rstd * g0.x, f[1] * rstd * g0.y); o.y = pk2(f[2] * rstd * g0.z, f[3] * rstd * g0.w);
            o.z = pk2(f[4] * rstd * g1.x, f[5] * rstd * g1.y); o.w = pk2(f[6] * rstd * g1.z, f[7] * rstd * g1.w);
            *p = o;
        }
        {
            bf16_t* kr = small + (size_t)m * SMALL_LD;
            const int j = lane & 31;
            const float t1 = bf2f(kr[j]), t2 = bf2f(kr[j + 32]);
            const float invf = exp2f(-(float)j * (13.287712379549449f / 32.f));
            const float ang = (float)pos[m] * invf;
            float sn, cs; sincosf(ang, &sn, &cs);
            if (lane < 32) { kr[j] = f2bf(t1 * cs - t2 * sn); kr[j + 32] = f2bf(t2 * cs + t1 * sn);
                float* tab = (float*)((unsigned char*)P.out + ((size_t)32 << 20)) + (size_t)m * 64; tab[j] = cs; tab[32 + j] = sn; }
        }
    }
}

#define DPPF(x, ctrl) __builtin_bit_cast(float, __builtin_amdgcn_update_dpp(0, __builtin_bit_cast(int, (x)), (ctrl), 0xF, 0xF, true))
template <int DQK, bool ALIBI, bool MLA>
DI void flash_unit(int wv, LAS unsigned char* lds, const bf16x8 (&qf)[DQK / 16],
                   const bf16_t* Kp, int kpitch, const bf16_t* K2p, int k2pitch, const bf16_t* Vp, int vpitch,
                   const int* posb, int q0, int posq, float slope_l2, f32x16 (&o)[4]) {
    constexpr int KP = (DQK + 8) * 2, VPB = 320, KOFF = 0, VOFF = 64 * KP, POSOFF = VOFF + 64 * VPB, STATOFF = POSOFF + 256, BUFSZ = STATOFF + 64;
    constexpr bool REV = ALIBI;
    constexpr int CPR = DQK / 8;
    constexpr int NKC = 64 * CPR / 512;
    const int tid_ = tid_from_wave(wv);
    const int tid = tid_, lane = tid & 63, r32 = lane & 31, hi = lane >> 5;
    const int wid = __builtin_amdgcn_readfirstlane(tid >> 6);
    const int NT = (q0 + 256) / 64;
    const int qw0 = q0 + 32 * wid, qrow = qw0 + r32;
    u32x4 kreg[NKC], vreg[2]; int preg = 0;
    unsigned koff[NKC]; const unsigned voff0 = (unsigned)((tid >> 4) * vpitch + 8 * (tid & 15));
#pragma unroll
    for (int i_ = 0; i_ < NKC; ++i_) { const int c_ = tid + 512 * i_, key_ = c_ / CPR, ch_ = c_ - key_ * CPR;
        koff[i_] = (MLA && ch_ >= 16) ? (unsigned)(key_ * k2pitch + 8 * (ch_ - 16)) : (unsigned)(key_ * kpitch + 8 * ch_); }
#define FL_GLOAD(t) do { const bf16_t* kt_ = Kp + (size_t)(64 * (t)) * kpitch; const bf16_t* k2t_ = MLA ? K2p + (size_t)(64 * (t)) * k2pitch : Kp; const bf16_t* vt_ = Vp + (size_t)(64 * (t)) * vpitch; \
        _Pragma("unroll") for (int i_ = 0; i_ < NKC; ++i_) { const int c_ = tid + 512 * i_, key_ = c_ / CPR, ch_ = c_ - key_ * CPR; \
            if (MLA) kreg[i_] = (ch_ < 16) ? *(const u32x4*)(kt_ + koff[i_]) : *(const u32x4*)(k2t_ + koff[i_]); \
            else kreg[i_] = *(const u32x4*)(kt_ + koff[i_]); } \
        vreg[0] = *(const u32x4*)(vt_ + voff0); vreg[1] = *(const u32x4*)(vt_ + (size_t)32 * vpitch + voff0); \
        if (ALIBI) { if (tid < 64) preg = (posb + 64 * (t))[tid]; } } while (0)
#define FL_LSTORE(buf) do { LAS unsigned char* b_ = lds + (buf) * BUFSZ; \
        _Pragma("unroll") for (int i_ = 0; i_ < NKC; ++i_) { const int c_ = tid + 512 * i_, key_ = c_ / CPR, ch_ = c_ - key_ * CPR; *(LAS u32x4*)(b_ + KOFF + key_ * KP + ch_ * 16) = kreg[i_]; } \
        _Pragma("unroll") for (int i_ = 0; i_ < 2; ++i_) { const int c_ = tid + 512 * i_, key_ = c_ >> 4, ch_ = c_ & 15; *(LAS u32x4*)(b_ + VOFF + key_ * VPB + ch_ * 16) = vreg[i_]; } \
        if (ALIBI) { if (tid < 64) *(LAS int*)(b_ + POSOFF + 4 * tid) = preg; \
              \
            { const u32x4 w_ = kreg[0]; float a0_ = bflo(w_.x), a1_ = bfhi(w_.x), a2_ = bflo(w_.y), a3_ = bfhi(w_.y), a4_ = bflo(w_.z), a5_ = bfhi(w_.z), a6_ = bflo(w_.w), a7_ = bfhi(w_.w); \
              float q_ = (a0_ * a0_ + a1_ * a1_) + (a2_ * a2_ + a3_ * a3_) + (a4_ * a4_ + a5_ * a5_) + (a6_ * a6_ + a7_ * a7_); \
              q_ += DPPF(q_, 0xB1); q_ += DPPF(q_, 0x4E); q_ += DPPF(q_, 0x141); q_ = fmaxf(q_, DPPF(q_, 0x140)); \
              q_ = fmaxf(q_, __shfl_xor(q_, 16)); q_ = fmaxf(q_, __shfl_xor(q_, 32)); \
              if (lane == 0) *(LAS float*)(b_ + STATOFF + 4 * wid) = q_; } \
            if (tid < 64) { int mn_ = preg, mx_ = preg; \
              _Pragma("unroll") for (int o_ = 1; o_ < 64; o_ <<= 1) { const int a_ = __shfl_xor(mn_, o_), c_ = __shfl_xor(mx_, o_); mn_ = a_ < mn_ ? a_ : mn_; mx_ = c_ > mx_ ? c_ : mx_; } \
              if (tid == 0) { *(LAS int*)(b_ + STATOFF + 32) = mn_; *(LAS int*)(b_ + STATOFF + 36) = mx_; } } } } while (0)
    float mrun = -INFINITY, lrun = 0.f;
#pragma unroll
    for (int d = 0; d < 4; ++d)
#pragma unroll
        for (int r = 0; r < 16; ++r) o[d][r] = 0.f;
    float qn = 0.f;
    if (ALIBI) {
#pragma unroll
        for (int s = 0; s < DQK / 16; ++s) { const u32x4 w = __builtin_bit_cast(u32x4, qf[s]);
            qn += (bflo(w.x) * bflo(w.x) + bfhi(w.x) * bfhi(w.x)) + (bflo(w.y) * bflo(w.y) + bfhi(w.y) * bfhi(w.y)) + (bflo(w.z) * bflo(w.z) + bfhi(w.z) * bfhi(w.z)) + (bflo(w.w) * bflo(w.w) + bfhi(w.w) * bfhi(w.w)); }
        qn += __shfl_xor(qn, 32);
        qn = sqrtf(qn) * 1.02f;
    }
    FL_GLOAD(REV ? NT - 1 : 0); FL_LSTORE(0);
    __syncthreads();
    const int i16 = lane & 15, g16 = (lane >> 4) & 1;
    for (int it = 0; it < NT; ++it) {
        const int t = REV ? NT - 1 - it : it;
        const int buf = it & 1;
        if (it + 1 < NT) FL_GLOAD(REV ? t - 1 : t + 1);
        bool skip = false;
        if (ALIBI) {
            const LAS unsigned char* sb = lds + buf * BUFSZ + STATOFF;
            const f32x4 s0 = *(const LAS f32x4*)sb, s1 = *(const LAS f32x4*)(sb + 16);
            const float k2 = fmaxf(fmaxf(fmaxf(s0.x, s0.y), fmaxf(s0.z, s0.w)), fmaxf(fmaxf(s1.x, s1.y), fmaxf(s1.z, s1.w)));
            const int pmn = *(const LAS int*)(sb + 32), pmx = *(const LAS int*)(sb + 36);
            int dm = posq - pmx; const int dm2 = pmn - posq; dm = dm > dm2 ? dm : dm2; dm = dm > 0 ? dm : 0;
            const bool c = (qn * sqrtf(k2) * 1.02f - slope_l2 * (float)dm - mrun) < -40.f;
            skip = __all(c) != 0;
        }
        if (64 * t <= qw0 + 31 && !skip) {
            const LAS unsigned char* kb = lds + buf * BUFSZ + KOFF + r32 * KP + hi * 16;
            f32x16 p0, p1;
#pragma unroll
            for (int r = 0; r < 16; ++r) { p0[r] = 0.f; p1[r] = 0.f; }
#pragma unroll
            for (int s = 0; s < DQK / 16; ++s) {
                const bf16x8 a0 = *(const LAS bf16x8*)(kb + s * 32), a1 = *(const LAS bf16x8*)(kb + 32 * KP + s * 32);
                p0 = MFMA32(a0, qf[s], p0); p1 = MFMA32(a1, qf[s], p1);
                if ((s & 3) == 3) __builtin_amdgcn_sched_barrier(0);
            }
            if (ALIBI) {
                const LAS unsigned char* pb = lds + buf * BUFSZ + POSOFF;
#pragma unroll
                for (int g = 0; g < 4; ++g) {
                    const i32x4 k0 = *(const LAS i32x4*)(pb + (8 * g + 4 * hi) * 4), k1 = *(const LAS i32x4*)(pb + (32 + 8 * g + 4 * hi) * 4);
#pragma unroll
                    for (int j = 0; j < 4; ++j) {
                        int d0 = posq - k0[j]; d0 = d0 < 0 ? -d0 : d0; int d1 = posq - k1[j]; d1 = d1 < 0 ? -d1 : d1;
                        p0[4 * g + j] -= slope_l2 * (float)d0; p1[4 * g + j] -= slope_l2 * (float)d1;
                    }
                }
            }
            if (64 * t + 63 > qw0) {
#pragma unroll
                for (int r = 0; r < 16; ++r) { const int key = 64 * t + crow(r, hi); if (key > qrow) p0[r] = -INFINITY; if (key + 32 > qrow) p1[r] = -INFINITY; }
            }
            float rm = fmaxf(p0[0], p1[0]);
#pragma unroll
            for (int r = 1; r < 16; ++r) rm = fmaxf(rm, fmaxf(p0[r], p1[r]));
            rm = fmaxf(rm, __shfl_xor(rm, 32));
            const float mnew = fmaxf(mrun, rm);
            if (__any(mnew > mrun)) {
                const float alpha = __builtin_amdgcn_exp2f(mrun - mnew);
                lrun *= alpha;
#pragma unroll
                for (int d = 0; d < 4; ++d)
#pragma unroll
                    for (int r = 0; r < 16; ++r) o[d][r] *= alpha;
            }
            mrun = mnew;
            float ps = 0.f;
#pragma unroll
            for (int r = 0; r < 16; ++r) { p0[r] = __builtin_amdgcn_exp2f(p0[r] - mnew); p1[r] = __builtin_amdgcn_exp2f(p1[r] - mnew); ps += p0[r] + p1[r]; }
            lrun += ps;
            bf16x8 pf[4];
            { u32x4 w;
              w.x = pk2(p0[0], p0[1]); w.y = pk2(p0[2], p0[3]); w.z = pk2(p0[4], p0[5]); w.w = pk2(p0[6], p0[7]); pf[0] = __builtin_bit_cast(bf16x8, w);
              w.x = pk2(p0[8], p0[9]); w.y = pk2(p0[10], p0[11]); w.z = pk2(p0[12], p0[13]); w.w = pk2(p0[14], p0[15]); pf[1] = __builtin_bit_cast(bf16x8, w);
              w.x = pk2(p1[0], p1[1]); w.y = pk2(p1[2], p1[3]); w.z = pk2(p1[4], p1[5]); w.w = pk2(p1[6], p1[7]); pf[2] = __builtin_bit_cast(bf16x8, w);
              w.x = pk2(p1[8], p1[9]); w.y = pk2(p1[10], p1[11]); w.z = pk2(p1[12], p1[13]); w.w = pk2(p1[14], p1[15]); pf[3] = __builtin_bit_cast(bf16x8, w); }
            const LAS unsigned char* vb = lds + buf * BUFSZ + VOFF + (4 * hi + (i16 >> 2)) * VPB + (16 * g16 + 4 * (i16 & 3)) * 2;
#pragma unroll
            for (int d = 0; d < 4; ++d)
#pragma unroll
                for (int s = 0; s < 4; ++s) {
                    const s16x4 lo = tr_read(vb + (16 * s) * VPB + d * 64), hh = tr_read(vb + (16 * s + 8) * VPB + d * 64);
                    o[d] = MFMA32(cat8(lo, hh), pf[s], o[d]);
                }
        }
        if (it + 1 < NT) FL_LSTORE(buf ^ 1);
        __syncthreads();
    }
    lrun += __shfl_xor(lrun, 32);
    const float il = 1.f / lrun;
#pragma unroll
    for (int d = 0; d < 4; ++d)
#pragma unroll
        for (int r = 0; r < 16; ++r) o[d][r] *= il;
#undef FL_GLOAD
#undef FL_LSTORE
}

DI void mla_unit(int wv, const Params& P, LAS unsigned char* lds, int u) {
    const int qb = 7 - (u >> 6), bh = u & 63, b = bh >> 3, h = bh & 7;
    const int tid_ = tid_from_wave(wv);
    const int tid = tid_, lane = tid & 63, r32 = lane & 31, hi = lane >> 5;
    const int wid = __builtin_amdgcn_readfirstlane(tid >> 6);
    const int q0 = 256 * qb, qrow = q0 + 32 * wid + r32;
    const size_t tok = (size_t)b * SEQ + qrow;
    const bf16_t* Q = (const bf16_t*)(P.ws + WS_Q); const bf16_t* KV = (const bf16_t*)(P.ws + WS_KV); const bf16_t* SM = (const bf16_t*)(P.ws + WS_SMALL);
    bf16_t* MIX = (bf16_t*)(P.ws + WS_HN);
    const int* pos = (const int*)P.in[1];
    const float qscale = 0.07216878364870322f * LOG2E;
    bf16x8 qf[12];
    const bf16_t* qp = Q + tok * Q_LD + h * 192 + 8 * hi;
#pragma unroll
    for (int s = 0; s < 8; ++s) {
        const u32x4 w = *(const u32x4*)(qp + 16 * s);
        u32x4 o; o.x = pk2(bflo(w.x) * qscale, bfhi(w.x) * qscale); o.y = pk2(bflo(w.y) * qscale, bfhi(w.y) * qscale);
        o.z = pk2(bflo(w.z) * qscale, bfhi(w.z) * qscale); o.w = pk2(bflo(w.w) * qscale, bfhi(w.w) * qscale);
        qf[s] = __builtin_bit_cast(bf16x8, o);
    }
#pragma unroll
    for (int s = 0; s < 2; ++s) {
        const u32x4 w1 = *(const u32x4*)(qp + 16 * (8 + s)), w2 = *(const u32x4*)(qp + 16 * (10 + s));
        float t1[8] = {bflo(w1.x), bfhi(w1.x), bflo(w1.y), bfhi(w1.y), bflo(w1.z), bfhi(w1.z), bflo(w1.w), bfhi(w1.w)};
        float t2[8] = {bflo(w2.x), bfhi(w2.x), bflo(w2.y), bfhi(w2.y), bflo(w2.z), bfhi(w2.z), bflo(w2.w), bfhi(w2.w)};
        float o1[8], o2[8];
        const float* tab = (const float*)((const unsigned char*)P.out + ((size_t)32 << 20)) + tok * 64 + 16 * s + 8 * hi;
        const f32x4 c0 = *(const f32x4*)tab, c1 = *(const f32x4*)(tab + 4), s0 = *(const f32x4*)(tab + 32), s1 = *(const f32x4*)(tab + 36);
        const float csv[8] = {c0.x, c0.y, c0.z, c0.w, c1.x, c1.y, c1.z, c1.w}, snv[8] = {s0.x, s0.y, s0.z, s0.w, s1.x, s1.y, s1.z, s1.w};
#pragma unroll
        for (int jj = 0; jj < 8; ++jj) {
            const float cs = csv[jj], sn = snv[jj];
            o1[jj] = (t1[jj] * cs - t2[jj] * sn) * qscale; o2[jj] = (t2[jj] * cs + t1[jj] * sn) * qscale;
        }
        u32x4 a, c; a.x = pk2(o1[0], o1[1]); a.y = pk2(o1[2], o1[3]); a.z = pk2(o1[4], o1[5]); a.w = pk2(o1[6], o1[7]);
        c.x = pk2(o2[0], o2[1]); c.y = pk2(o2[2], o2[3]); c.z = pk2(o2[4], o2[5]); c.w = pk2(o2[6], o2[7]);
        qf[8 + s] = __builtin_bit_cast(bf16x8, a); qf[10 + s] = __builtin_bit_cast(bf16x8, c);
    }
    f32x16 o[4];
    flash_unit<192, false, true>(wv, lds, qf, KV + (size_t)b * SEQ * KV_LD + h * 256, KV_LD, SM + (size_t)b * SEQ * SMALL_LD, SMALL_LD,
                                 KV + (size_t)b * SEQ * KV_LD + h * 256 + 128, KV_LD, nullptr, q0, 0, 0.f, o);
    bf16_t* op = MIX + tok * DM + h * 128;
#pragma unroll
    for (int d = 0; d < 4; ++d)
#pragma unroll
        for (int g = 0; g < 4; ++g) { u32x2 w; w.x = pk2(o[d][4 * g], o[d][4 * g + 1]); w.y = pk2(o[d][4 * g + 2], o[d][4 * g + 3]); *(u32x2*)(op + 32 * d + 8 * g + 4 * hi) = w; }
}

DI void diff_unit(int wv, const Params& P, LAS unsigned char* lds, int u) {
    const int qb = 7 - (u >> 6), bh = u & 63, b = bh >> 3, h = bh & 7;
    const int tid_ = tid_from_wave(wv);
    const int tid = tid_, lane = tid & 63, r32 = lane & 31, hi = lane >> 5;
    const int wid = __builtin_amdgcn_readfirstlane(tid >> 6);
    const int q0 = 256 * qb, qrow = q0 + 32 * wid + r32;
    const size_t tok = (size_t)b * SEQ + qrow;
    const bf16_t* PR = (const bf16_t*)(P.ws + WS_PROJ);
    bf16_t* MIX = (bf16_t*)(P.ws + WS_HN);
    const int* pos = (const int*)P.in[1];
    const float qscale = 0.125f * LOG2E;
    const float slope_l2 = exp2f(-(float)(h + 1)) * LOG2E;
    const int posq = pos[tok];
    f32x16 o1[4], o2[4];
#pragma unroll
    for (int c = 0; c < 2; ++c) {
        bf16x8 qf[4];
        const bf16_t* qp = PR + tok * PROJ_LD + 1024 + h * 128 + c * 64 + 8 * hi;
#pragma unroll
        for (int s = 0; s < 4; ++s) {
            const u32x4 w = *(const u32x4*)(qp + 16 * s);
            u32x4 o; o.x = pk2(bflo(w.x) * qscale, bfhi(w.x) * qscale); o.y = pk2(bflo(w.y) * qscale, bfhi(w.y) * qscale);
            o.z = pk2(bflo(w.z) * qscale, bfhi(w.z) * qscale); o.w = pk2(bflo(w.w) * qscale, bfhi(w.w) * qscale);
            qf[s] = __builtin_bit_cast(bf16x8, o);
        }
        const bf16_t* kp = PR + (size_t)b * SEQ * PROJ_LD + 2048 + h * 128 + c * 64;
        const bf16_t* vp = PR + (size_t)b * SEQ * PROJ_LD + 3072 + h * 128;
        if (c == 0) {
            flash_unit<64, true, false>(wv, lds, qf, kp, PROJ_LD, nullptr, 0, vp, PROJ_LD, pos + (size_t)b * SEQ, q0, posq, slope_l2, o1);
            LAS float* sv = (LAS float*)(lds + 60160) + tid;
#pragma unroll
            for (int r = 0; r < 16; ++r) { sv[r * 512] = o1[2][r]; sv[(16 + r) * 512] = o1[3][r]; }
            sv[32 * 512] = o1[1][14]; sv[33 * 512] = o1[1][15];
        } else flash_unit<64, true, false>(wv, lds, qf, kp, PROJ_LD, nullptr, 0, vp, PROJ_LD, pos + (size_t)b * SEQ, q0, posq, slope_l2, o2);
    }
    {
        const LAS float* sv = (const LAS float*)(lds + 60160) + tid_from_wave(wv);
#pragma unroll
        for (int r = 0; r < 16; ++r) { o1[2][r] = sv[r * 512]; o1[3][r] = sv[(16 + r) * 512]; }
        o1[1][14] = sv[32 * 512]; o1[1][15] = sv[33 * 512];
    }
    const int tidb = tid_from_wave(wv), laneb = tidb & 63, hib = laneb >> 5;
    const size_t tokb = (size_t)b * SEQ + q0 + 32 * (tidb >> 6) + (laneb & 31);
    float d1 = P.in[28][laneb] * P.in[29][laneb], d2 = P.in[30][laneb] * P.in[31][laneb];
    d1 = wave_sum(d1); d2 = wave_sum(d2);
    const float lam = expf(d1) - expf(d2) + LAMBDA_INIT;
    float ss = 0.f;
#pragma unroll
    for (int d = 0; d < 4; ++d)
#pragma unroll
        for (int r = 0; r < 16; ++r) { const float v = o1[d][r] - lam * o2[d][r]; o1[d][r] = v; ss += v * v; }
    ss += __shfl_xor(ss, 32);
    const float rstd = (1.f / sqrtf(ss * (1.f / 128.f) + RMS_EPS)) * (1.f - LAMBDA_INIT);
    const float* dn = P.in[32];
    bf16_t* op = MIX + tokb * DM + 1024 + h * 128;
#pragma unroll
    for (int d = 0; d < 4; ++d)
#pragma unroll
        for (int g = 0; g < 4; ++g) { const int e = 32 * d + 8 * g + 4 * hib; const f32x4 gg = *(const f32x4*)(dn + e);
            u32x2 w; w.x = pk2(o1[d][4 * g] * rstd * gg.x, o1[d][4 * g + 1] * rstd * gg.y); w.y = pk2(o1[d][4 * g + 2] * rstd * gg.z, o1[d][4 * g + 3] * rstd * gg.w);
            *(u32x2*)(op + e) = w; }
}

constexpr size_t OUT_KH = 0;
constexpr size_t OUT_DEC = (size_t)NTOK * 512 * 2;
constexpr size_t OUT_U = OUT_DEC + (size_t)256 * 512 * 4;
constexpr size_t OUT_DSEG = OUT_U + (size_t)96 * 131072;
constexpr size_t OUT_ROPE = (size_t)32 << 20;
DI float log_sigmoid_(float x) { return fminf(x, 0.f) - __logf(1.f + __expf(-fabsf(x))); }
DI void gla_prep_item(int wv, const Params& P, LAS unsigned char* lds, int item) {
    const int tid_ = tid_from_wave(wv);
    const int tid = tid_;
    const int b = item >> 7, h = (item >> 5) & 3, ch = item & 31;
    bf16_t* PR = (bf16_t*)(P.ws + WS_PROJ); const bf16_t* SM = (const bf16_t*)(P.ws + WS_SMALL);
    bf16_t* KH = (bf16_t*)((unsigned char*)P.out + OUT_KH); float* DEC = (float*)((unsigned char*)P.out + OUT_DEC);
    LAS float* glrs = (LAS float*)lds; LAS float* tots = (LAS float*)(lds + 4096);
    const int d = tid & 127, part = tid >> 7;
    const size_t tok0 = (size_t)b * SEQ + 64 * ch;
    float wg[16];
#pragma unroll
    for (int r = 0; r < 16; ++r) wg[r] = P.in[13][r * 512 + h * 128 + d];
    const float bg = P.in[14][h * 128 + d];
    if (tid < 256) { const int tk = tid >> 2, r0 = (tid & 3) * 4; const u32x2 w = *(const u32x2*)(SM + (tok0 + tk) * SMALL_LD + 64 + r0);
        *(LAS f32x4*)(glrs + tk * 16 + r0) = (f32x4){bflo(w.x), bfhi(w.x), bflo(w.y), bfhi(w.y)}; }
    float qv[16], kv[16];
#pragma unroll
    for (int i = 0; i < 16; ++i) { const size_t a = (tok0 + 16 * part + i) * PROJ_LD + 1024 + h * 128 + d; qv[i] = bf2f(PR[a]); kv[i] = bf2f(PR[a + 512]); }
    __syncthreads();
    float cum[16]; float run = 0.f;
#pragma unroll
    for (int i = 0; i < 16; ++i) {
        const LAS f32x4* gp = (const LAS f32x4*)(glrs + (16 * part + i) * 16);
        const f32x4 g0 = gp[0], g1 = gp[1], g2 = gp[2], g3 = gp[3];
        float x = bg;
        x += g0.x * wg[0] + g0.y * wg[1] + g0.z * wg[2] + g0.w * wg[3];
        x += g1.x * wg[4] + g1.y * wg[5] + g1.z * wg[6] + g1.w * wg[7];
        x += g2.x * wg[8] + g2.y * wg[9] + g2.z * wg[10] + g2.w * wg[11];
        x += g3.x * wg[12] + g3.y * wg[13] + g3.z * wg[14] + g3.w * wg[15];
        run += log_sigmoid_(x) * (1.f / 16.f);
        cum[i] = run;
    }
    tots[part * 128 + d] = run;
    __syncthreads();
    float pre = 0.f, last = 0.f;
#pragma unroll
    for (int pp = 0; pp < 4; ++pp) { const float tv = tots[pp * 128 + d]; if (pp < part) pre += tv; last += tv; }
    if (part == 0) DEC[(size_t)(b * 32 + ch) * 512 + h * 128 + d] = __expf(last);
#pragma unroll
    for (int i = 0; i < 16; ++i) {
        const size_t tk = tok0 + 16 * part + i; const float c = cum[i] + pre;
        PR[tk * PROJ_LD + 1024 + h * 128 + d] = f2bf(qv[i] * __expf(c) * 0.08838834764831845f);
        PR[tk * PROJ_LD + 1536 + h * 128 + d] = f2bf(kv[i] * __expf(-c));
        KH[tk * 512 + h * 128 + d] = f2bf(kv[i] * __expf(last - c));
    }
    __syncthreads();
}

template <bool STATE_ONLY>
DI void gla_unit(int wv, const Params& P, LAS unsigned char* lds, int b, int h, int seg) {
    constexpr int QP = 288, VP2 = 544, PP = 144, OP = 528;
    constexpr int OFF_Q = 0, OFF_K = OFF_Q + 64 * QP, OFF_KH = OFF_K + 64 * QP, OFF_V = OFF_KH + 64 * QP, OFF_P = OFF_V + 64 * VP2;
    constexpr int OFF_DEC = OFF_P + 64 * PP, OFF_SS = OFF_DEC + 128 * 4, OFF_END = OFF_SS + 64 * 8 * 4, OFF_O = 0;
    static_assert(OFF_END <= LDS_RING && 64 * OP <= OFF_KH, "gla lds");
    const int tid_ = tid_from_wave(wv);
    const int tid = tid_, lane = tid & 63, i16 = lane & 15, quad = lane >> 4;
    const int ch0 = 8 * seg, bh = b * 4 + h;
    f32x4* UU = (f32x4*)((unsigned char*)P.out + OUT_U); float* DSEG = (float*)((unsigned char*)P.out + OUT_DSEG);
    const int wid = __builtin_amdgcn_readfirstlane(tid >> 6);
    const bf16_t* PR = (const bf16_t*)(P.ws + WS_PROJ);
    const bf16_t* KH = (const bf16_t*)((const unsigned char*)P.out + OUT_KH); const float* DEC = (const float*)((const unsigned char*)P.out + OUT_DEC);
    bf16_t* MIX = (bf16_t*)(P.ws + WS_HN);
    const int e0 = 32 * wid;
    f32x4 st[8][2];
#pragma unroll
    for (int a = 0; a < 8; ++a)
#pragma unroll
        for (int c = 0; c < 2; ++c) st[a][c] = (f32x4){0.f, 0.f, 0.f, 0.f};
    if (!STATE_ONLY) {
        for (int sg = 0; sg < seg; ++sg) {
            const f32x4* up = UU + ((size_t)(bh * 3 + sg) * 8 + wid) * 1024 + lane;
            const float* dp = DSEG + (size_t)(bh * 3 + sg) * 128 + 4 * quad;
#pragma unroll
            for (int a = 0; a < 8; ++a) { const f32x4 dc = *(const f32x4*)(dp + 16 * a);
                st[a][0] = st[a][0] * dc + up[(a * 2 + 0) * 64]; st[a][1] = st[a][1] * dc + up[(a * 2 + 1) * 64]; }
        }
    }
    float dprod = 1.f;
    const float gn0 = P.in[15][e0 + i16], gn1 = P.in[15][e0 + 16 + i16];
    LAS float* decs = (LAS float*)(lds + OFF_DEC); LAS float* sss = (LAS float*)(lds + OFF_SS);
    u32x4 rq[2], rk[2], rh[2], rv[4]; float rd = 0.f;
    const unsigned oq = (unsigned)((tid >> 4) * PROJ_LD + 8 * (tid & 15)), okh = (unsigned)((tid >> 4) * 512 + 8 * (tid & 15)), ovv = (unsigned)((tid >> 5) * PROJ_LD + 8 * (tid & 31));
    const unsigned omix = (unsigned)((tid >> 5) * DM + 8 * (tid & 31));
#define GLA_GLOAD(ch) do { const size_t t0_ = (size_t)b * SEQ + 64 * (ch); \
        _Pragma("unroll") for (int i_ = 0; i_ < 2; ++i_) { \
            const bf16_t* pq_ = PR + (t0_ + 32 * i_) * PROJ_LD + 1024 + h * 128; const bf16_t* ph_ = KH + (t0_ + 32 * i_) * 512 + h * 128; \
            if (!STATE_ONLY) { rq[i_] = *(const u32x4*)(pq_ + oq); rk[i_] = *(const u32x4*)(pq_ + 512 + oq); } rh[i_] = *(const u32x4*)(ph_ + okh); } \
        if (STATE_ONLY) { _Pragma("unroll") for (int i_ = 0; i_ < 4; ++i_) { const bf16_t* pv_ = PR + (t0_ + 16 * i_) * PROJ_LD + 2048 + h * 256; rv[i_] = *(const u32x4*)(pv_ + ovv); } } \
        if (tid < 128) rd = (DEC + (size_t)(b * 32 + (ch)) * 512 + h * 128)[tid]; } while (0)
    GLA_GLOAD(ch0);
    for (int ch = ch0; ch < ch0 + 8; ++ch) {
        const size_t tok0 = (size_t)b * SEQ + 64 * ch;
#pragma unroll
        for (int i = 0; i < 2; ++i) { const int c = tid + 512 * i, j = c >> 4, cc = c & 15;
            if (!STATE_ONLY) { *(LAS u32x4*)(lds + OFF_Q + j * QP + cc * 16) = rq[i]; *(LAS u32x4*)(lds + OFF_K + j * QP + cc * 16) = rk[i]; } *(LAS u32x4*)(lds + OFF_KH + j * QP + cc * 16) = rh[i]; }
#pragma unroll
        for (int i = 0; i < 4; ++i) { if (!STATE_ONLY) { const bf16_t* pv_ = PR + (tok0 + 16 * i) * PROJ_LD + 2048 + h * 256; rv[i] = *(const u32x4*)(pv_ + ovv); }
            else { const int c = tid + 512 * i, j = c >> 5, cc = c & 31; *(LAS u32x4*)(lds + OFF_V + j * VP2 + cc * 16) = rv[i]; } }
        if (tid < 128) { decs[tid] = rd; dprod *= rd; }
        __syncthreads();
        if (!STATE_ONLY) {
#pragma unroll
        for (int x = 0; x < 2; ++x) {
            const int tl = 2 * wid + x, it = tl >> 2, jt = tl & 3;
            f32x4 acc = (f32x4){0.f, 0.f, 0.f, 0.f};
            if (jt <= it) {
#pragma unroll
                for (int s = 0; s < 4; ++s) {
                    const bf16x8 a = *(const LAS bf16x8*)(lds + OFF_Q + (16 * it + i16) * QP + (32 * s + 8 * quad) * 2);
                    const bf16x8 bb = *(const LAS bf16x8*)(lds + OFF_K + (16 * jt + i16) * QP + (32 * s + 8 * quad) * 2);
                    acc = MFMA16(a, bb, acc);
                }
            }
#pragma unroll
            for (int r = 0; r < 4; ++r) { const int i = 16 * it + 4 * quad + r, j = 16 * jt + i16; const float v = (j <= i) ? acc[r] : 0.f;
                *(LAS bf16_t*)(lds + OFF_P + i * PP + j * 2) = f2bf(v); }
        }
        }
        if (!STATE_ONLY) {
#pragma unroll
        for (int i = 0; i < 4; ++i) { const int c = tid + 512 * i, j = c >> 5, cc = c & 31; *(LAS u32x4*)(lds + OFF_V + j * VP2 + cc * 16) = rv[i]; }
        __syncthreads();
        }
        bf16x8 vf[2][2];
#pragma unroll
        for (int s = 0; s < 2; ++s)
#pragma unroll
            for (int et = 0; et < 2; ++et) {
                const LAS unsigned char* vb = lds + OFF_V + (32 * s + 8 * quad + (i16 >> 2)) * VP2 + (e0 + 16 * et + 4 * (i16 & 3)) * 2;
                vf[s][et] = cat8(tr_read(vb), tr_read(vb + 4 * VP2));
            }
        if (!STATE_ONLY) {
        f32x4 oo[4][2];
#pragma unroll
        for (int it = 0; it < 4; ++it)
#pragma unroll
            for (int et = 0; et < 2; ++et) oo[it][et] = (f32x4){0.f, 0.f, 0.f, 0.f};
#pragma unroll
        for (int s = 0; s < 2; ++s)
#pragma unroll
            for (int it = 0; it < 4; ++it) {
                const bf16x8 a = *(const LAS bf16x8*)(lds + OFF_P + (16 * it + i16) * PP + (32 * s + 8 * quad) * 2);
                oo[it][0] = MFMA16(a, vf[s][0], oo[it][0]); oo[it][1] = MFMA16(a, vf[s][1], oo[it][1]);
                if (it == 3) __builtin_amdgcn_sched_barrier(0);
            }
#pragma unroll
        for (int s = 0; s < 4; ++s) {
            bf16x8 sb[2];
#pragma unroll
            for (int et = 0; et < 2; ++et) { u32x4 w; w.x = pk2(st[2 * s][et][0], st[2 * s][et][1]); w.y = pk2(st[2 * s][et][2], st[2 * s][et][3]);
                w.z = pk2(st[2 * s + 1][et][0], st[2 * s + 1][et][1]); w.w = pk2(st[2 * s + 1][et][2], st[2 * s + 1][et][3]); sb[et] = __builtin_bit_cast(bf16x8, w); }
#pragma unroll
            for (int it = 0; it < 4; ++it) {
                const LAS unsigned char* qa = lds + OFF_Q + (16 * it + i16) * QP + (32 * s + 4 * quad) * 2;
                const u32x2 lo = *(const LAS u32x2*)qa, hh = *(const LAS u32x2*)(qa + 32);
                const bf16x8 a = __builtin_bit_cast(bf16x8, (u32x4){lo.x, lo.y, hh.x, hh.y});
                oo[it][0] = MFMA16(a, sb[0], oo[it][0]); oo[it][1] = MFMA16(a, sb[1], oo[it][1]);
            }
            __builtin_amdgcn_sched_barrier(0);
        }
#pragma unroll
        for (int it = 0; it < 4; ++it)
#pragma unroll
            for (int r = 0; r < 4; ++r) {
                float s2 = dpp_add16(oo[it][0][r] * oo[it][0][r] + oo[it][1][r] * oo[it][1][r]);
                if (i16 == 0) sss[(16 * it + 4 * quad + r) * 8 + wid] = s2;
            }
        __syncthreads();
#pragma unroll
        for (int it = 0; it < 4; ++it)
#pragma unroll
            for (int r = 0; r < 4; ++r) {
                const int i = 16 * it + 4 * quad + r;
                const LAS f32x4* sp = (const LAS f32x4*)(sss + i * 8); const f32x4 s0 = sp[0], s1 = sp[1];
                const float tot = (s0.x + s0.y) + (s0.z + s0.w) + (s1.x + s1.y) + (s1.z + s1.w);
                const float rstd = 1.f / sqrtf(tot * (1.f / 256.f) + RMS_EPS);
                *(LAS bf16_t*)(lds + OFF_O + i * OP + (e0 + i16) * 2) = f2bf(oo[it][0][r] * rstd * gn0);
                *(LAS bf16_t*)(lds + OFF_O + i * OP + (e0 + 16 + i16) * 2) = f2bf(oo[it][1][r] * rstd * gn1);
            }
        }
        if (ch + 1 < ch0 + 8) GLA_GLOAD(ch + 1);
        u32x4 gpre[4];
        if (!STATE_ONLY) {
#pragma unroll
        for (int i = 0; i < 4; ++i) gpre[i] = *(const u32x4*)((PR + (tok0 + 16 * i) * PROJ_LD + 3072 + h * 256) + ovv);
        }
#pragma unroll
        for (int dt = 0; dt < 8; ++dt) {
            const f32x4 dc = *(const LAS f32x4*)(decs + 16 * dt + 4 * quad);
            st[dt][0] *= dc; st[dt][1] *= dc;
#pragma unroll
            for (int s = 0; s < 2; ++s) {
                const LAS unsigned char* kb = lds + OFF_KH + (32 * s + 8 * quad + (i16 >> 2)) * QP + (16 * dt + 4 * (i16 & 3)) * 2;
                const bf16x8 a = cat8(tr_read(kb), tr_read(kb + 4 * QP));
                st[dt][0] = MFMA16(a, vf[s][0], st[dt][0]); st[dt][1] = MFMA16(a, vf[s][1], st[dt][1]);
            }
            if (dt & 1) __builtin_amdgcn_sched_barrier(0);
        }
        __syncthreads();
        if (!STATE_ONLY) {
#pragma unroll
        for (int i = 0; i < 4; ++i) { const int c = tid + 512 * i, row = c >> 5, cc = c & 31;
            const u32x4 ov = *(const LAS u32x4*)(lds + OFF_O + row * OP + cc * 16);
            const u32x4 gv = gpre[i];
            u32x4 w;
            w.x = pk2(bflo(ov.x) * siluf_(bflo(gv.x)), bfhi(ov.x) * siluf_(bfhi(gv.x)));
            w.y = pk2(bflo(ov.y) * siluf_(bflo(gv.y)), bfhi(ov.y) * siluf_(bfhi(gv.y)));
            w.z = pk2(bflo(ov.z) * siluf_(bflo(gv.z)), bfhi(ov.z) * siluf_(bfhi(gv.z)));
            w.w = pk2(bflo(ov.w) * siluf_(bflo(gv.w)), bfhi(ov.w) * siluf_(bfhi(gv.w)));
            *(u32x4*)((MIX + (tok0 + 16 * i) * DM + 1024 + h * 256) + omix) = w; }
        __syncthreads();
        }
    }
    if (STATE_ONLY) {
        f32x4* up = UU + ((size_t)(bh * 3 + seg) * 8 + wid) * 1024 + lane;
#pragma unroll
        for (int a = 0; a < 8; ++a) { up[(a * 2 + 0) * 64] = st[a][0]; up[(a * 2 + 1) * 64] = st[a][1]; }
        if (tid < 128) DSEG[(size_t)(bh * 3 + seg) * 128 + tid] = dprod;
    }
#undef GLA_GLOAD
}

DI float gelu_tanh_(float x) { const float u = 0.7978845608028654f * (x + 0.044715f * x * x * x); const float t = 1.f - 2.f * __builtin_amdgcn_rcpf(__expf(2.f * u) + 1.f); return 0.5f * x * (1.f + t); }
DI void s5_unit(int wv, const Params& P, LAS unsigned char* lds, int item) {
    const int tid_ = tid_from_wave(wv);
    const int tid = tid_, lane = tid & 63, i16 = lane & 15, quad = lane >> 4;
    const int wid = __builtin_amdgcn_readfirstlane(tid >> 6);
    const int pair = item * 8 + wid, b = pair >> 6, g = pair & 63;
    LAS unsigned char* wl = lds + wid * 16384;
    LAS float* bus = (LAS float*)wl;
    LAS unsigned char* xs = wl + 8192;
    bf16_t* PR = (bf16_t*)(P.ws + WS_PROJ);
    const float* a_re = P.in[18]; const float* a_im = P.in[19]; const float* b_re = P.in[21]; const float* b_im = P.in[22];
    const float* c_re = P.in[23]; const float* c_im = P.in[24];
    const float dt = expf(P.in[20][g]);
    float ar, ai;
    { const float lr = a_re[g * 64 + lane], li = a_im[g * 64 + lane]; const float mag = expf(lr * dt); float sn, cs; sincosf(li * dt, &sn, &cs); ar = mag * cs; ai = mag * sn; }
    bf16x8 bfr[8];
#pragma unroll
    for (int k = 0; k < 4; ++k) {
        const int n = 16 * k + i16;
        const float lr = a_re[g * 64 + n], li = a_im[g * 64 + n]; const float mag = expf(lr * dt); float sn, cs; sincosf(li * dt, &sn, &cs);
        const float zr = mag * cs - 1.f, zi = mag * sn, den = lr * lr + li * li;
        const float fr = (zr * lr + zi * li) / den, fi = (zi * lr - zr * li) / den;
        float vr[8], vi[8];
#pragma unroll
        for (int j = 0; j < 8; ++j) { vr[j] = 0.f; vi[j] = 0.f; }
        if (quad < 2) {
            const f32x4 r0 = *(const f32x4*)(b_re + ((size_t)g * 64 + n) * 16 + 8 * quad), r1 = *(const f32x4*)(b_re + ((size_t)g * 64 + n) * 16 + 8 * quad + 4);
            const f32x4 m0 = *(const f32x4*)(b_im + ((size_t)g * 64 + n) * 16 + 8 * quad), m1 = *(const f32x4*)(b_im + ((size_t)g * 64 + n) * 16 + 8 * quad + 4);
            const float br[8] = {r0.x, r0.y, r0.z, r0.w, r1.x, r1.y, r1.z, r1.w}, bi[8] = {m0.x, m0.y, m0.z, m0.w, m1.x, m1.y, m1.z, m1.w};
#pragma unroll
            for (int j = 0; j < 8; ++j) { vr[j] = fr * br[j] - fi * bi[j]; vi[j] = fr * bi[j] + fi * br[j]; }
        }
        u32x4 w; w.x = pk2(vr[0], vr[1]); w.y = pk2(vr[2], vr[3]); w.z = pk2(vr[4], vr[5]); w.w = pk2(vr[6], vr[7]); bfr[k] = __builtin_bit_cast(bf16x8, w);
        w.x = pk2(vi[0], vi[1]); w.y = pk2(vi[2], vi[3]); w.z = pk2(vi[4], vi[5]); w.w = pk2(vi[6], vi[7]); bfr[4 + k] = __builtin_bit_cast(bf16x8, w);
    }
    bf16x8 cfr[4];
#pragma unroll
    for (int s = 0; s < 4; ++s) {
        const float* cp = (s < 2 ? c_re : c_im) + ((size_t)g * 16 + i16) * 64 + 32 * (s & 1) + 8 * quad;
        const f32x4 c0 = *(const f32x4*)cp, c1 = *(const f32x4*)(cp + 4);
        const float sg = s < 2 ? 1.f : -1.f;
        u32x4 w; w.x = pk2(sg * c0.x, sg * c0.y); w.y = pk2(sg * c0.z, sg * c0.w); w.z = pk2(sg * c1.x, sg * c1.y); w.w = pk2(sg * c1.z, sg * c1.w);
        cfr[s] = __builtin_bit_cast(bf16x8, w);
    }
    const float dsk = P.in[25][g * 16 + i16];
    float xr = 0.f, xi = 0.f;
    const bf16_t* ub = PR + (size_t)b * SEQ * PROJ_LD + g * 16;
    bf16_t* zb = (bf16_t*)(P.ws + WS_Q) + (size_t)b * SEQ * Q_LD + g * 16;
    u32x4 ua_n = (u32x4){0u, 0u, 0u, 0u}; bf16_t uv_n[4];
    if (quad < 2) ua_n = *(const u32x4*)(ub + (size_t)i16 * PROJ_LD + 8 * quad);
#pragma unroll
    for (int r = 0; r < 4; ++r) uv_n[r] = ub[(size_t)(4 * quad + r) * PROJ_LD + i16];
    for (int t0 = 0; t0 < SEQ; t0 += 16) {
        const u32x4 ua = ua_n;
        float uv[4];
#pragma unroll
        for (int r = 0; r < 4; ++r) uv[r] = bf2f(uv_n[r]);
        if (t0 + 16 < SEQ) {
            if (quad < 2) ua_n = *(const u32x4*)(ub + (size_t)(t0 + 16 + i16) * PROJ_LD + 8 * quad);
#pragma unroll
            for (int r = 0; r < 4; ++r) uv_n[r] = ub[(size_t)(t0 + 16 + 4 * quad + r) * PROJ_LD + i16];
        }
        const bf16x8 af = __builtin_bit_cast(bf16x8, ua);
#pragma unroll
        for (int nt = 0; nt < 8; ++nt) {
            const f32x4 c = MFMA16(af, bfr[nt], ((f32x4){0.f, 0.f, 0.f, 0.f}));
#pragma unroll
            for (int r = 0; r < 4; ++r) bus[(4 * quad + r) * 128 + 16 * nt + i16] = c[r];
        }
        LDS_WAIT();
        float br_[16], bi_[16];
#pragma unroll
        for (int t = 0; t < 16; ++t) { br_[t] = bus[t * 128 + lane]; bi_[t] = bus[t * 128 + 64 + lane]; }
        LDS_WAIT();
        __builtin_amdgcn_sched_barrier(0);
#pragma unroll
        for (int t = 0; t < 16; ++t) {
            const float nr = ar * xr - ai * xi + br_[t], ni = ar * xi + ai * xr + bi_[t];
            xr = nr; xi = ni; br_[t] = nr; bi_[t] = ni;
        }
        __builtin_amdgcn_sched_barrier(0);
#pragma unroll
        for (int t = 0; t < 16; ++t) {
            *(LAS bf16_t*)(xs + t * 272 + lane * 2) = f2bf(br_[t]);
            *(LAS bf16_t*)(xs + t * 272 + (64 + lane) * 2) = f2bf(bi_[t]);
        }
        LDS_WAIT();
        f32x4 y = (f32x4){0.f, 0.f, 0.f, 0.f};
#pragma unroll
        for (int s = 0; s < 4; ++s) { const bf16x8 a = *(const LAS bf16x8*)(xs + i16 * 272 + (32 * s + 8 * quad) * 2); y = MFMA16(a, cfr[s], y); }
#pragma unroll
        for (int r = 0; r < 4; ++r) { const float yv = y[r] + dsk * uv[r]; zb[(size_t)(t0 + 4 * quad + r) * Q_LD + i16] = f2bf(gelu_tanh_(yv)); }
        LDS_WAIT();
    }
}

#define XB_TMO      128
#define XB_XCNT(j)  (256  + 64 * (j))
#define XB_XSUB(j)  (1280 + 64 * (j))
#define XB_XGEN(j)  (2304 + 64 * (j))
#define XB_TOP      3328
#define XB_TOPGEN   3392
#define XCD_BAR_WORDS 3456
#define XB_SPIN_CAP (1u << 18)
DI unsigned xb_ld(unsigned* p)              { return __hip_atomic_load(p, __ATOMIC_RELAXED, __HIP_MEMORY_SCOPE_AGENT); }
DI unsigned xb_add(unsigned* p, unsigned v) { return __hip_atomic_fetch_add(p, v, __ATOMIC_RELAXED, __HIP_MEMORY_SCOPE_AGENT); }
DI unsigned xb_xcc_id() { return (unsigned)__builtin_amdgcn_s_getreg((3 << 11) | 20) & 0xFu; }
#define XB_SPIN(cond, bar) do { unsigned _sp = 0; while (cond) { __builtin_amdgcn_s_sleep(1); \
    if ((++_sp & 255u) == 0u) { if (xb_ld(&(bar)[XB_TMO])) break; if (_sp > XB_SPIN_CAP) { atomicAdd(&(bar)[XB_TMO], 1u); break; } } } } while (0)
struct XcdBarrier { unsigned* bar; unsigned x; volatile LAS unsigned* st; };
DI XcdBarrier xcd_barrier_post(unsigned* bar, volatile LAS unsigned* st) {
    XcdBarrier b; b.bar = bar; b.x = xb_xcc_id(); b.st = st;
    if (threadIdx.x == 0) (void)xb_add(&bar[XB_XCNT(b.x)], 1u);
    return b;
}
DI void xcd_barrier_complete(unsigned* bar, unsigned x, unsigned& nloc, unsigned& nx) {
    const unsigned G = gridDim.x * gridDim.y * gridDim.z;
    unsigned sum, cnt, mine, sp = 0u;
    for (;;) {
        sum = 0u; cnt = 0u; mine = 0u;
#pragma unroll
        for (unsigned j = 0; j < 16; ++j) { const unsigned c = xb_ld(&bar[XB_XCNT(j)]); sum += c; cnt += (c > 0u) ? 1u : 0u; mine = (j == x) ? c : mine; }
        if (sum == G) break;
        __builtin_amdgcn_s_sleep(1);
        if ((++sp & 255u) == 0u) { if (xb_ld(&bar[XB_TMO])) break; if (sp > XB_SPIN_CAP) { atomicAdd(&bar[XB_TMO], 1u); break; } }
    }
    nloc = mine > 0u ? mine : 1u; nx = cnt > 0u ? cnt : 1u;
}
DI void xcd_barrier(const XcdBarrier& b) {
    asm volatile("s_waitcnt vmcnt(0)" ::: "memory");
    __syncthreads();
    if (threadIdx.x == 0) {
        unsigned* bar = b.bar;
        __builtin_amdgcn_s_waitcnt(0);
        unsigned nloc = b.st[0], nx = b.st[1];
        if (nloc == 0u) { xcd_barrier_complete(bar, b.x, nloc, nx); b.st[0] = nloc; b.st[1] = nx; }
        const unsigned old = xb_add(&bar[XB_XSUB(b.x)], 1u);
        const unsigned gen = old / nloc;
        if (old + 1u == (gen + 1u) * nloc) {
            __builtin_amdgcn_fence(__ATOMIC_RELEASE, "agent");
            asm volatile("s_waitcnt vmcnt(0)" ::: "memory");
            const unsigned og = xb_add(&bar[XB_TOP], 1u);
            const unsigned tg = og / nx;
            if (og + 1u == (tg + 1u) * nx) xb_add(&bar[XB_TOPGEN], 1u);
            else XB_SPIN(xb_ld(&bar[XB_TOPGEN]) == tg, bar);
            __builtin_amdgcn_fence(__ATOMIC_ACQUIRE, "agent");
            xb_add(&bar[XB_XGEN(b.x)], 1u);
            asm volatile("s_waitcnt vmcnt(0)" ::: "memory");
        } else {
            XB_SPIN(xb_ld(&bar[XB_XGEN(b.x)]) == gen, bar);
            __builtin_amdgcn_fence(__ATOMIC_ACQUIRE, "agent");
            asm volatile("s_waitcnt vmcnt(0)" ::: "memory");
        }
    }
    __syncthreads();
}

#ifndef FUSED
#define FUSED 1
#endif
#ifndef DUP_PHASE
#define DUP_PHASE -1
#endif
#ifndef DUP_SUB
#define DUP_SUB 0
#endif
#ifndef EXTRA_SYNCS
#define EXTRA_SYNCS 0
#endif

template <int PH, int REP = 0> DI void run_phase(int wv, const Params& P, LAS unsigned char* lds) {
    const int tid_ = tid_from_wave(wv);
    const int tid = tid_, lane = tid & 63, wave = __builtin_amdgcn_readfirstlane(tid >> 6);
    const int G = gridDim.x, bid = blockIdx.x;
    const int gw = bid * 8 + wave, ngw = G * 8;
    unsigned char* ws = P.ws;
    unsigned* ctl = (unsigned*)(ws + WS_CTL);
    LAS int* qslot = (LAS int*)(lds + MISC_OFF);
    bf16_t* HN = (bf16_t*)(ws + WS_HN); bf16_t* PROJ = (bf16_t*)(ws + WS_PROJ); bf16_t* SMALL = (bf16_t*)(ws + WS_SMALL);
    bf16_t* QB = (bf16_t*)(ws + WS_Q); bf16_t* KVB = (bf16_t*)(ws + WS_KV); bf16_t* ACT = (bf16_t*)(ws + WS_ACT);
    float* H = P.out; float* SS = (float*)(ws + WS_SS);
    if constexpr (PH == 0) {
        if (bid == 0 && tid < 8) ctl[32 * tid] = 0u;
        p0_prologue(P, lds, gw, ngw, wave, lane);
    } else if constexpr (PH == 1) {
        pg8::Gemm g{HN, (const bf16_t*)(ws + WS_WIN0), NTOK, NIN0, DM, DM}; pg8::StaticOrder S; S.init(NTOK, NIN0, G, bid);
        pg8::EpiBf16 E{PROJ, PROJ_LD, 16, SMALL, SMALL_LD, nullptr}; pg8::gemm_phase(lds, g, S, E, wv);
    } else if constexpr (PH == 2) {
        p2_rowpass(P, gw, ngw, lane);
        for (int it = bid; it < 1024; it += G) gla_prep_item(wv, P, lds, it);
    } else if constexpr (PH == 3) {
        { pg8::Gemm g{PROJ, (const bf16_t*)(ws + WS_WUQ), NTOK, 1536, 512, PROJ_LD}; pg8::StaticOrder S; S.init(NTOK, 1536, G, bid);
          pg8::EpiBf16 E{QB, Q_LD, 1 << 30, nullptr, 0, nullptr}; pg8::gemm_phase(lds, g, S, E, wv); }
        { pg8::Gemm g{PROJ + 512, (const bf16_t*)(ws + WS_WUKV), NTOK, 2048, 512, PROJ_LD}; pg8::StaticOrder S; S.init(NTOK, 2048, G, bid);
          pg8::EpiBf16 E{KVB, KV_LD, 1 << 30, nullptr, 0, nullptr}; pg8::gemm_phase(lds, g, S, E, wv); }
        { const int shift = (G >= 224) ? 128 : 0;
          for (int it = bid - shift; it >= 0 && it < 96; it += G) { const int bh = it / 3, sg = it - bh * 3; gla_unit<true>(wv, P, lds, bh >> 2, bh & 3, sg); } }
    } else if constexpr (PH == 4) {
        if (REP == 0 || DUP_SUB != 1) for (;;) {
            if (tid_from_wave(wv) == 0) *qslot = (int)atomicAdd(ctl + 32 + 128 * REP, 1u);
            __syncthreads();
            const int item = *qslot;
            __syncthreads();
            if (item >= 128) break;
            { const int sg = 3 - (item >> 5), bh = item & 31; gla_unit<false>(wv, P, lds, bh >> 2, bh & 3, sg); }
        }
        if (REP == 0 || DUP_SUB != 2) for (;;) {
            if (tid_from_wave(wv) == 0) *qslot = (int)atomicAdd(ctl + 0 + 128 * REP, 1u);
            __syncthreads();
            const int item = *qslot;
            __syncthreads();
            if (item >= 512) break;
            mla_unit(wv, P, lds, item);
        }
    } else if constexpr (PH == 5 || PH == 13) {
        pg8::Gemm g{HN, (const bf16_t*)(ws + (PH == 5 ? WS_WOUT0 : WS_WOUT1)), NTOK, DM, DM, DM}; pg8::StaticOrder S; S.init(NTOK, DM, G, bid);
        pg8::EpiResF32 E{PH == 5 ? P.in[0] : H, H, DM, KVB, SS + (PH == 5 ? 0 : 2) * NTOK}; pg8::gemm_phase(lds, g, S, E, wv);
    } else if constexpr (PH == 7 || PH == 15) {
        pg8::Gemm g{KVB, (const bf16_t*)(ws + (PH == 7 ? WS_WGU0 : WS_WGU1)), NTOK, 2 * FFH, DM, DM}; pg8::StaticOrder S; S.init(NTOK, 2 * FFH, G, bid);
        if (REP == 1 && DUP_SUB == 9) { pg8::EpiNone E{}; pg8::gemm_phase(lds, g, S, E, wv); } else {
        pg8::EpiSwiGLU E{ACT, FFH, SS + (PH == 7 ? 0 : 2) * NTOK}; pg8::gemm_phase(lds, g, S, E, wv); }
    } else if constexpr (PH == 8 || PH == 16) {
        pg8::Gemm g{ACT, (const bf16_t*)(ws + (PH == 8 ? WS_WDN0 : WS_WDN1)), NTOK, DM, FFH, FFH}; pg8::StaticOrder S; S.init(NTOK, DM, G, bid);
        if constexpr (PH == 8) { pg8::EpiResF32 E{H, H, DM, KVB, SS + 1 * NTOK}; pg8::gemm_phase(lds, g, S, E, wv); }
        else { pg8::EpiResNormOut E{H, H, DM, SS + 3 * NTOK, ctl + 2048, P.in[4]}; pg8::gemm_phase(lds, g, S, E, wv); }
    } else if constexpr (PH == 10) {
        pg8::Gemm g{KVB, (const bf16_t*)(ws + WS_WIN1), NTOK, 4096, DM, DM}; pg8::StaticOrder S; S.init(NTOK, 4096, G, bid);
        pg8::EpiBf16 E{PROJ, PROJ_LD, 1 << 30, nullptr, 0, SS + 1 * NTOK}; pg8::gemm_phase(lds, g, S, E, wv);
    } else if constexpr (PH == 11) {
        if (REP == 0 || DUP_SUB != 1) for (;;) {
            if (tid_from_wave(wv) == 0) *qslot = (int)atomicAdd(ctl + 96 + 128 * REP, 1u);
            __syncthreads();
            const int item = *qslot;
            __syncthreads();
            if (item >= 64) break;
            s5_unit(wv, P, lds, item);
        }
        if (REP == 0 || DUP_SUB != 2) for (;;) {
            if (tid_from_wave(wv) == 0) *qslot = (int)atomicAdd(ctl + 64 + 128 * REP, 1u);
            __syncthreads();
            const int item = *qslot;
            __syncthreads();
            if (item >= 512) break;
            diff_unit(wv, P, lds, item);
        }
    } else if constexpr (PH == 12) {
        pg8::Gemm g{QB, (const bf16_t*)(ws + WS_WGLU), NTOK, 1024, 1024, Q_LD}; pg8::StaticOrder S; S.init(NTOK, 1024, G, bid);
        pg8::EpiGLU E{QB, Q_LD, P.in[27], HN, DM}; pg8::gemm_phase(lds, g, S, E, wv);
    } else if constexpr (PH == 17) {
        final_norm_phase(H, P.in[4], SS + 3 * NTOK, gw, ngw, lane);
    }
}

#if FUSED
__global__ void __launch_bounds__(512, 2) hybrid_fwd(Params P) {
    extern __shared__ __attribute__((aligned(16))) unsigned char lds_raw[];
    LAS unsigned char* lds = (LAS unsigned char*)lds_raw;
    cg::grid_group grid = cg::this_grid();
    const int wv = __builtin_amdgcn_readfirstlane((int)threadIdx.x >> 6);
    { LAS unsigned* misc = (LAS unsigned*)(lds + MISC_OFF); if (threadIdx.x < 16) misc[threadIdx.x] = 0u; }
    __syncthreads();
    const XcdBarrier xbar = xcd_barrier_post((unsigned*)(P.ws + WS_CTL) + 4096, (volatile LAS unsigned*)(lds + MISC_OFF + 32));
    if (P.ws == nullptr) grid.sync();
#define SEAM(k) xcd_barrier(xbar)
#define PHASE(k) run_phase<k>(wv, P, lds); SEAM(k); if (DUP_PHASE == k) { run_phase<k, 1>(wv, P, lds); SEAM(k); }
    PHASE(0) PHASE(1) PHASE(2) PHASE(3) PHASE(4) PHASE(5) PHASE(7) PHASE(8)
    PHASE(10) PHASE(11) PHASE(12) PHASE(13) PHASE(15)
    for (int i_ = 0; i_ < EXTRA_SYNCS; ++i_) xcd_barrier(xbar);
    run_phase<16>(wv, P, lds);
#undef PHASE
}
#else
template <int PH> __global__ void __launch_bounds__(512, 2) phase_kernel(Params P) {
    extern __shared__ __attribute__((aligned(16))) unsigned char lds_raw[];
    run_phase<PH>(__builtin_amdgcn_readfirstlane((int)threadIdx.x >> 6), P, (LAS unsigned char*)lds_raw);
}
template <int PH> static void launch_phase(const Params& p, int grid, hipStream_t stream) {
    (void)hipFuncSetAttribute((const void*)phase_kernel<PH>, hipFuncAttributeMaxDynamicSharedMemorySize, LDS_BYTES);
    hipLaunchKernelGGL(phase_kernel<PH>, dim3(grid), dim3(512), LDS_BYTES, stream, p);
}
#endif

extern "C" void kernel_launch(void* const* d_in, const int* in_sizes, int n_in, void* d_out, int out_size, void* d_ws, size_t ws_size, hipStream_t stream) {
    static int grid = 0;
    if (grid == 0) {
        if (n_in != 34 || out_size != NTOK * DM || ws_size < WS_END) { fprintf(stderr, "kernel_launch: unexpected shapes n_in %d out %d ws %zu (need %zu)\n", n_in, out_size, ws_size, (size_t)WS_END); grid = -1; return; }
        int dev = 0, cus = 0;
        (void)hipGetDevice(&dev);
        (void)hipDeviceGetAttribute(&cus, hipDeviceAttributeMultiprocessorCount, dev);
#if FUSED
        int per_cu = 0;
        (void)hipFuncSetAttribute((const void*)hybrid_fwd, hipFuncAttributeMaxDynamicSharedMemorySize, LDS_BYTES);
        (void)hipOccupancyMaxActiveBlocksPerMultiprocessor(&per_cu, (const void*)hybrid_fwd, 512, LDS_BYTES);
        if (per_cu < 1) fprintf(stderr, "kernel_launch: occupancy query says %d blocks per CU\n", per_cu);
#endif
        (void)hipGetLastError();
        grid = cus;
    }
    if (grid < 0) return;
    Params p{};
    for (int i = 0; i < 34; ++i) p.in[i] = (const float*)d_in[i];
    p.out = (float*)d_out; p.ws = (unsigned char*)d_ws;
#if FUSED
    if (hipMemsetAsync((char*)d_ws + WS_CTL, 0, 32768, stream) != hipSuccess) { fprintf(stderr, "kernel_launch: memset of control words failed\n"); return; }
    void* args[] = {&p};
    hipError_t e = hipLaunchCooperativeKernel((const void*)hybrid_fwd, dim3(grid), dim3(512), args, LDS_BYTES, stream);
    if (e != hipSuccess) fprintf(stderr, "cooperative launch failed: %s (grid %d)\n", hipGetErrorString(e), grid);
#else
    launch_phase<0>(p, grid, stream); launch_phase<1>(p, grid, stream); launch_phase<2>(p, grid, stream); launch_phase<3>(p, grid, stream);
    launch_phase<4>(p, grid, stream); launch_phase<5>(p, grid, stream); launch_phase<6>(p, grid, stream); launch_phase<7>(p, grid, stream);
    launch_phase<8>(p, grid, stream); launch_phase<9>(p, grid, stream); launch_phase<10>(p, grid, stream); launch_phase<11>(p, grid, stream);
    launch_phase<12>(p, grid, stream); launch_phase<13>(p, grid, stream); launch_phase<14>(p, grid, stream); launch_phase<15>(p, grid, stream);
    launch_phase<16>(p, grid, stream); launch_phase<17>(p, grid, stream);
#endif
}
```

```cpp
#include <hip/hip_runtime.h>
#include <hip/hip_cooperative_groups.h>
#include <cstdio>
#include <cstdint>
#include <cmath>
namespace cg = cooperative_groups;

#define DI __device__ __forceinline__
#define LAS __attribute__((address_space(3)))
typedef unsigned short bf16_t;
typedef short bf16x8 __attribute__((ext_vector_type(8)));
typedef short s16x4 __attribute__((ext_vector_type(4)));
typedef float f32x4 __attribute__((ext_vector_type(4)));
typedef float f32x2 __attribute__((ext_vector_type(2)));
typedef float f32x16 __attribute__((ext_vector_type(16)));
typedef unsigned u32x4 __attribute__((ext_vector_type(4)));
typedef unsigned u32x2 __attribute__((ext_vector_type(2)));
typedef int i32x4 __attribute__((ext_vector_type(4)));
typedef __bf16 bf16x2_t __attribute__((ext_vector_type(2)));

#define MFMA32(a, b, c) __builtin_amdgcn_mfma_f32_32x32x16_bf16((a), (b), (c), 0, 0, 0)
#define MFMA16(a, b, c) __builtin_amdgcn_mfma_f32_16x16x32_bf16((a), (b), (c), 0, 0, 0)
#define LDS_WAIT() asm volatile("s_waitcnt lgkmcnt(0)" ::: "memory")

DI unsigned pk2(float lo, float hi) { f32x2 v = {lo, hi}; bf16x2_t b = __builtin_convertvector(v, bf16x2_t); return __builtin_bit_cast(unsigned, b); }
DI float bflo(unsigned u) { return __uint_as_float(u << 16); }
DI float bfhi(unsigned u) { return __uint_as_float(u & 0xffff0000u); }
DI float bf2f(bf16_t u) { return __uint_as_float(((unsigned)u) << 16); }
DI bf16_t f2bf(float f) { return (bf16_t)(pk2(f, 0.f) & 0xffffu); }
DI float wave_sum(float v) {
#pragma unroll
    for (int o = 1; o < 64; o <<= 1) v += __shfl_xor(v, o);
    return v;
}
DI int tid_from_wave(int wv) { int l; asm volatile("v_mbcnt_lo_u32_b32 %0, -1, 0\n\tv_mbcnt_hi_u32_b32 %0, -1, %0" : "=v"(l)); int t = wv * 64 + l; asm volatile("" : "+v"(t)); return t; }
DI float dpp_add16(float x) {
    x += __builtin_bit_cast(float, __builtin_amdgcn_update_dpp(0, __builtin_bit_cast(int, x), 0xB1, 0xF, 0xF, true));
    x += __builtin_bit_cast(float, __builtin_amdgcn_update_dpp(0, __builtin_bit_cast(int, x), 0x4E, 0xF, 0xF, true));
    x += __builtin_bit_cast(float, __builtin_amdgcn_update_dpp(0, __builtin_bit_cast(int, x), 0x141, 0xF, 0xF, true));
    x += __builtin_bit_cast(float, __builtin_amdgcn_update_dpp(0, __builtin_bit_cast(int, x), 0x140, 0xF, 0xF, true));
    return x;
}
DI int crow(int r, int hi) { return (r & 3) + 8 * (r >> 2) + 4 * hi; }
DI s16x4 tr_read(const LAS unsigned char* p) { return __builtin_bit_cast(s16x4, __builtin_amdgcn_ds_read_tr16_b64_v4i16((LAS s16x4*)p)); }
DI bf16x8 cat8(s16x4 lo, s16x4 hi) { return (bf16x8){lo[0], lo[1], lo[2], lo[3], hi[0], hi[1], hi[2], hi[3]}; }
DI float sigmoidf_(float x) { return __builtin_amdgcn_rcpf(1.f + __expf(-x)); }
DI float siluf_(float x) { return x * __builtin_amdgcn_rcpf(1.f + __expf(-x)); }

constexpr int NTOK = 16384, SEQ = 2048, NBATCH = 8, DM = 2048, FFH = 5632;
constexpr int PROJ_LD = 4096, SMALL_LD = 128, Q_LD = 1536, KV_LD = 2048;
constexpr int NIN0 = 4352;
constexpr float RMS_EPS = 1e-6f;
constexpr float LOG2E = 1.4426950408889634f;
constexpr float LAMBDA_INIT = 0.35550906759f;

constexpr size_t WS_CTL = 0;
constexpr size_t WS_WIN0 = 1048576;
constexpr size_t WS_SS = 65536;
constexpr size_t WS_WUQ = WS_WIN0 + (size_t)NIN0 * 2048 * 2;
constexpr size_t WS_WUKV = WS_WUQ + (size_t)1536 * 512 * 2;
constexpr size_t WS_WOUT0 = WS_WUKV + (size_t)2048 * 512 * 2;
constexpr size_t WS_WGU0 = WS_WOUT0 + (size_t)2048 * 2048 * 2;
constexpr size_t WS_WDN0 = WS_WGU0 + (size_t)11264 * 2048 * 2;
constexpr size_t WS_WIN1 = WS_WDN0 + (size_t)2048 * 5632 * 2;
constexpr size_t WS_WGLU = WS_WIN1 + (size_t)4096 * 2048 * 2;
constexpr size_t WS_WOUT1 = WS_WGLU + (size_t)1024 * 1024 * 2;
constexpr size_t WS_WGU1 = WS_WOUT1 + (size_t)2048 * 2048 * 2;
constexpr size_t WS_WDN1 = WS_WGU1 + (size_t)11264 * 2048 * 2;
constexpr size_t WS_HN = WS_WDN1 + (size_t)2048 * 5632 * 2;
constexpr size_t WS_PROJ = WS_HN + (size_t)NTOK * 2048 * 2;
constexpr size_t WS_SMALL = WS_PROJ + (size_t)NTOK * 4096 * 2;
constexpr size_t WS_Q = WS_SMALL + (size_t)NTOK * 128 * 2;
constexpr size_t WS_KV = WS_Q + (size_t)NTOK * 1536 * 2;
constexpr size_t WS_END = WS_KV + (size_t)NTOK * 2048 * 2;
constexpr size_t WS_ACT = WS_PROJ;
static_assert(WS_ACT + (size_t)NTOK * FFH * 2 <= WS_END, "ACT overlay");
static_assert(WS_END <= (size_t)512 * 1024 * 1024, "workspace");

constexpr int LDS_RING = 131072, MISC_OFF = LDS_RING, LDS_BYTES = LDS_RING + 1024;

namespace pg8 {
constexpr int BM = 256, BK = 64, HALF = 128, HTB = HALF * BK * 2, NXCD = 8, WGM = 4;
DI int lds_byte(int r, int c) { const int st = (r >> 4) * 2 + (c >> 5), rr = r & 15, cc = c & 31, ob = rr * 64 + cc * 2; return st * 1024 + (ob ^ (((ob >> 9) & 1) << 5)); }
DI void stage_rc(int b, int& R, int& C) { const int st = b / 1024, sb = b % 1024, swz = sb ^ (((sb >> 9) & 1) << 5); R = (st >> 1) * 16 + swz / 64; C = (st & 1) * 32 + (swz % 64) / 2; }
DI int perm32(int rho) { const int n = rho >> 4, i = rho & 15; return 8 * (i >> 2) + 4 * n + (i & 3); }

struct Unit { int pm, pn; };
struct Gemm { const bf16_t* A; const bf16_t* Bt; int M, N, K, lda; };

struct StaticOrder {
    int nM, nN, nwg, G, c;
    DI void init(int M, int N, int G_, int c_) { nM = M / BM; nN = N / BM; nwg = nM * nN; G = G_; c = c_; }
    DI bool next(int i, Unit& u) const {
        const long L = (long)i * G + c; if (L >= nwg) return false;
        int wgid = (int)L; { const int q = nwg / NXCD, r = nwg % NXCD, xcd = wgid % NXCD, off = wgid / NXCD; wgid = (xcd < r ? xcd * (q + 1) : r * (q + 1) + (xcd - r) * q) + off; }
        const int nig = WGM * nN, gid = wgid / nig, fm = gid * WGM, gsz = (nM - fm) < WGM ? (nM - fm) : WGM;
        u.pm = fm + ((wgid % nig) % gsz); u.pn = (wgid % nig) / gsz; return true;
    }
};


struct EpiBf16 {
    static constexpr bool PERM = true;
    bf16_t* O; int ldc; int split_pn; bf16_t* O2; int ld2; const float* ss;
    DI void operator()(const f32x4 (&acc)[2][2][4][2], const Unit& u, int wr, int wc, int fr, int fq) const {
        const int row0 = u.pm * BM + wr * 64 + fr;
        const bool sp = u.pn >= split_pn;
        bf16_t* base = sp ? O2 : O; const int ld = sp ? ld2 : ldc;
        const int col0 = (sp ? 0 : u.pn * BM) + wc * 32 + 8 * fq;
        float rsv[8];
#pragma unroll
        for (int q = 0; q < 8; ++q) rsv[q] = ss ? ss[row0 + (q >> 2) * HALF + (q & 3) * 16] : 0.f;
#pragma unroll
        for (int q = 0; q < 8; ++q) rsv[q] = ss ? 1.f / sqrtf(rsv[q] * (1.f / DM) + RMS_EPS) : 1.f;
#pragma unroll
        for (int ai = 0; ai < 2; ++ai)
#pragma unroll
            for (int m = 0; m < 4; ++m) { const int row = row0 + ai * HALF + m * 16; bf16_t* rowp = base + (size_t)row * ld + col0;
                const float rs = rsv[ai * 4 + m];
#pragma unroll
                for (int bj = 0; bj < 2; ++bj) { if (sp && bj == 1) continue;
                    const f32x4 v0 = acc[ai][bj][m][0] * rs, v1 = acc[ai][bj][m][1] * rs;
                    u32x4 w; w.x = pk2(v0[0], v0[1]); w.y = pk2(v0[2], v0[3]); w.z = pk2(v1[0], v1[1]); w.w = pk2(v1[2], v1[3]);
                    *(u32x4*)(rowp + bj * HALF) = w; } }
    }
};
struct EpiNone { static constexpr bool PERM = true; DI void operator()(const f32x4 (&acc)[2][2][4][2], const Unit& u, int wr, int wc, int fr, int fq) const { float t = 0.f;
#pragma unroll
    for (int a = 0; a < 2; ++a) for (int b = 0; b < 2; ++b) for (int m = 0; m < 4; ++m) for (int n = 0; n < 2; ++n) t += acc[a][b][m][n][0];
    asm volatile("" :: "v"(t)); } };
struct EpiResF32 {
    static constexpr bool PERM = false;
    const float* base; float* out; int ldc; bf16_t* hb; float* ss;
    DI void operator()(const f32x4 (&acc)[2][2][4][2], const Unit& u, int wr, int wc, int fr, int fq) const {
        const int col0 = u.pn * BM + wc * 32 + 4 * fq;
#pragma unroll
        for (int ai = 0; ai < 2; ++ai) {
            f32x4 pre[4][2][2];
#pragma unroll
            for (int m = 0; m < 4; ++m) { const size_t off = (size_t)(u.pm * BM + ai * HALF + wr * 64 + m * 16 + fr) * ldc + col0;
#pragma unroll
                for (int bj = 0; bj < 2; ++bj)
#pragma unroll
                    for (int n = 0; n < 2; ++n) pre[m][bj][n] = *(const f32x4*)(base + off + bj * HALF + n * 16); }
            asm volatile("" ::: "memory");
#pragma unroll
            for (int m = 0; m < 4; ++m) { const int row = u.pm * BM + ai * HALF + wr * 64 + m * 16 + fr; const size_t off = (size_t)row * ldc + col0;
                float sq = 0.f;
#pragma unroll
                for (int bj = 0; bj < 2; ++bj)
#pragma unroll
                    for (int n = 0; n < 2; ++n) { const f32x4 bs = pre[m][bj][n]; const f32x4 v = bs + acc[ai][bj][m][n];
                        *(f32x4*)(out + off + bj * HALF + n * 16) = v;
                        if (ss) sq += (v.x * v.x + v.y * v.y) + (v.z * v.z + v.w * v.w);
                        if (hb) { u32x2 w; w.x = pk2(v.x, v.y); w.y = pk2(v.z, v.w); *(u32x2*)(hb + off + bj * HALF + n * 16) = w; } }
                if (ss) { sq += __shfl_xor(sq, 16); sq += __shfl_xor(sq, 32); if (fq == 0) atomicAdd(ss + row, sq); } }
        }
    }
};
struct EpiResNormOut {
    static constexpr bool PERM = false;
    const float* base; float* out; int ldc; float* ss; unsigned* cnt; const float* g;
    DI void operator()(f32x4 (&acc)[2][2][4][2], const Unit& u, int wr, int wc, int fr, int fq) const {
        const int col0 = u.pn * BM + wc * 32 + 4 * fq;
#pragma unroll
        for (int ai = 0; ai < 2; ++ai) {
            f32x4 pre[4][2][2];
#pragma unroll
            for (int m = 0; m < 4; ++m) { const size_t off = (size_t)(u.pm * BM + ai * HALF + wr * 64 + m * 16 + fr) * ldc + col0;
#pragma unroll
                for (int bj = 0; bj < 2; ++bj)
#pragma unroll
                    for (int n = 0; n < 2; ++n) pre[m][bj][n] = *(const f32x4*)(base + off + bj * HALF + n * 16); }
            asm volatile("" ::: "memory");
#pragma unroll
            for (int m = 0; m < 4; ++m) { const int row = u.pm * BM + ai * HALF + wr * 64 + m * 16 + fr;
                float sq = 0.f;
#pragma unroll
                for (int bj = 0; bj < 2; ++bj)
#pragma unroll
                    for (int n = 0; n < 2; ++n) { const f32x4 v = pre[m][bj][n] + acc[ai][bj][m][n]; acc[ai][bj][m][n] = v; sq += (v.x * v.x + v.y * v.y) + (v.z * v.z + v.w * v.w); }
                sq += __shfl_xor(sq, 16); sq += __shfl_xor(sq, 32); if (fq == 0) atomicAdd(ss + row, sq); }
        }
        asm volatile("s_waitcnt vmcnt(0)" ::: "memory");
        unsigned* cw = cnt + 32 * u.pm;
        if (fr == 0 && fq == 0) __hip_atomic_fetch_add(cw, 1u, __ATOMIC_RELAXED, __HIP_MEMORY_SCOPE_AGENT);
        { unsigned sp = 0; while ((unsigned)__builtin_amdgcn_readfirstlane((int)__hip_atomic_load(cw, __ATOMIC_RELAXED, __HIP_MEMORY_SCOPE_AGENT)) < 64u) { __builtin_amdgcn_s_sleep(2); if (++sp > (1u << 20)) break; } }
        asm volatile("" ::: "memory");
        f32x4 gv[2][2];
#pragma unroll
        for (int bj = 0; bj < 2; ++bj)
#pragma unroll
            for (int n = 0; n < 2; ++n) gv[bj][n] = *(const f32x4*)(g + col0 + bj * HALF + n * 16);
#pragma unroll
        for (int ai = 0; ai < 2; ++ai)
#pragma unroll
            for (int m = 0; m < 4; ++m) { const int row = u.pm * BM + ai * HALF + wr * 64 + m * 16 + fr; const size_t off = (size_t)row * ldc + col0;
                const float rs = 1.f / sqrtf(__hip_atomic_load(ss + row, __ATOMIC_RELAXED, __HIP_MEMORY_SCOPE_AGENT) * (1.f / DM) + RMS_EPS);
#pragma unroll
                for (int bj = 0; bj < 2; ++bj)
#pragma unroll
                    for (int n = 0; n < 2; ++n) *(f32x4*)(out + off + bj * HALF + n * 16) = acc[ai][bj][m][n] * rs * gv[bj][n]; }
    }
};
struct EpiSwiGLU {
    static constexpr bool PERM = true;
    bf16_t* O; int ldc; const float* ss;
    DI void operator()(const f32x4 (&acc)[2][2][4][2], const Unit& u, int wr, int wc, int fr, int fq) const {
        const int row0 = u.pm * BM + wr * 64 + fr, col0 = u.pn * HALF + wc * 32 + 8 * fq;
        float rsv[8];
#pragma unroll
        for (int q = 0; q < 8; ++q) rsv[q] = ss[row0 + (q >> 2) * HALF + (q & 3) * 16];
#pragma unroll
        for (int q = 0; q < 8; ++q) rsv[q] = 1.f / sqrtf(rsv[q] * (1.f / DM) + RMS_EPS);
#pragma unroll
        for (int ai = 0; ai < 2; ++ai)
#pragma unroll
            for (int m = 0; m < 4; ++m) { const int row = row0 + ai * HALF + m * 16; bf16_t* rowp = O + (size_t)row * ldc + col0;
                const float rs = rsv[ai * 4 + m];
                float r[8];
#pragma unroll
                for (int n = 0; n < 2; ++n)
#pragma unroll
                    for (int j = 0; j < 4; ++j) { const float g = acc[ai][0][m][n][j] * rs, up = acc[ai][1][m][n][j] * rs; r[n * 4 + j] = siluf_(g) * up; }
                u32x4 w; w.x = pk2(r[0], r[1]); w.y = pk2(r[2], r[3]); w.z = pk2(r[4], r[5]); w.w = pk2(r[6], r[7]);
                *(u32x4*)rowp = w; }
    }
};
struct EpiGLU {
    static constexpr bool PERM = true;
    const bf16_t* Z; int ldz; const float* bias; bf16_t* O; int ldc;
    DI void operator()(const f32x4 (&acc)[2][2][4][2], const Unit& u, int wr, int wc, int fr, int fq) const {
        const int row0 = u.pm * BM + wr * 64 + fr, col0 = u.pn * BM + wc * 32 + 8 * fq;
#pragma unroll
        for (int bj = 0; bj < 2; ++bj) {
            const f32x4 b0 = *(const f32x4*)(bias + col0 + bj * HALF), b1 = *(const f32x4*)(bias + col0 + bj * HALF + 4);
#pragma unroll
            for (int ai = 0; ai < 2; ++ai)
#pragma unroll
                for (int m = 0; m < 4; ++m) { const size_t r = (size_t)(row0 + ai * HALF + m * 16);
                    const u32x4 zz = *(const u32x4*)(Z + r * ldz + col0 + bj * HALF);
                    const f32x4 v0 = acc[ai][bj][m][0] + b0, v1 = acc[ai][bj][m][1] + b1;
                    u32x4 w;
                    w.x = pk2(bflo(zz.x) * sigmoidf_(v0[0]), bfhi(zz.x) * sigmoidf_(v0[1]));
                    w.y = pk2(bflo(zz.y) * sigmoidf_(v0[2]), bfhi(zz.y) * sigmoidf_(v0[3]));
                    w.z = pk2(bflo(zz.z) * sigmoidf_(v1[0]), bfhi(zz.z) * sigmoidf_(v1[1]));
                    w.w = pk2(bflo(zz.w) * sigmoidf_(v1[2]), bfhi(zz.w) * sigmoidf_(v1[3]));
                    *(u32x4*)(O + r * ldc + col0 + bj * HALF) = w; }
        }
    }
};

#ifndef GEMM_SP2
#define GEMM_SP2 true
#endif
template <class Epi, bool SP2 = GEMM_SP2>
DI void gemm_phase(LAS unsigned char* lds, const Gemm g, const StaticOrder& S, const Epi& E, int wv) {
    const int tid_ = tid_from_wave(wv);
    const int tid = tid_, wid = __builtin_amdgcn_readfirstlane(tid >> 6), lane = tid & 63, wr = wid >> 2, wc = wid & 3, fr = lane & 15, fq = lane >> 4;
    const int K = g.K, nt = K / BK, lda = g.lda;
    unsigned voffA[2], voffB[2];
#pragma unroll
    for (int i = 0; i < 2; ++i) { int R, C; stage_rc(tid * 16 + i * 8192, R, C); const int Rb = Epi::PERM ? ((R & ~31) + perm32(R & 31)) : R;
        voffA[i] = (unsigned)(R * lda + C) * 2u; voffB[i] = (unsigned)(Rb * K + C) * 2u; }
    const size_t kstep = (size_t)(BK * 2);
    const size_t hstepA = (size_t)HALF * lda * 2, hstepB = (size_t)HALF * K * 2;
    const size_t tstepA = 2 * hstepA, tstepB = 2 * hstepB;
    const unsigned ldsw = (unsigned)wid * 1024u;
    const int aoff = lds_byte(wr * 64 + fr, fq * 8), boff = lds_byte(wc * 32 + fr, fq * 8);
#define PG8_SA(b, h) (((b) * 2 + (h)) * HTB)
#define PG8_SB(b, h) ((4 + (b) * 2 + (h)) * HTB)
#define PG8_STAGE(bufoff, gbase, voff) do { _Pragma("unroll") for (int _i = 0; _i < 2; ++_i) \
        __builtin_amdgcn_global_load_lds((const unsigned*)((const char*)(gbase) + (voff)[_i]), (LAS unsigned*)(lds + (bufoff) + ldsw + _i * 8192), 16, 0, 0); } while (0)
#define PG8_LDA(dst, b, h) do { _Pragma("unroll") for (int m = 0; m < 4; ++m) _Pragma("unroll") for (int k = 0; k < 2; ++k) dst[m][k] = *(const LAS bf16x8*)(lds + PG8_SA(b, h) + aoff + m * 2048 + k * 1024); } while (0)
#define PG8_LDB(dst, b, h) do { _Pragma("unroll") for (int n = 0; n < 2; ++n) _Pragma("unroll") for (int k = 0; k < 2; ++k) dst[n][k] = *(const LAS bf16x8*)(lds + PG8_SB(b, h) + boff + n * 2048 + k * 1024); } while (0)
#define PG8_MMA(ai, bj, At, Bt) do { __builtin_amdgcn_s_setprio(1); _Pragma("unroll") for (int m = 0; m < 4; ++m) _Pragma("unroll") for (int n = 0; n < 2; ++n) _Pragma("unroll") for (int k = 0; k < 2; ++k) \
        acc[ai][bj][m][n] = __builtin_amdgcn_mfma_f32_16x16x32_bf16(Bt[n][k], At[m][k], acc[ai][bj][m][n], 0, 0, 0); __builtin_amdgcn_s_setprio(0); } while (0)
#define PG8_WAIT_V(n) asm volatile("s_waitcnt vmcnt(" #n ")" ::: "memory")
#define PG8_WAIT_L(n) asm volatile("s_waitcnt lgkmcnt(" #n ")" ::: "memory")
#define PG8_BAR __builtin_amdgcn_s_barrier()
#define PG8_SCHED __builtin_amdgcn_sched_barrier(0)
    Unit cur, nxt; int ui = 0;
    if (!S.next(0, cur)) return;
    f32x4 acc[2][2][4][2];
#pragma unroll
    for (int a = 0; a < 2; ++a)
#pragma unroll
        for (int b = 0; b < 2; ++b)
#pragma unroll
            for (int m = 0; m < 4; ++m)
#pragma unroll
                for (int n = 0; n < 2; ++n) acc[a][b][m][n] = (f32x4){0.f, 0.f, 0.f, 0.f};
    bf16x8 At[4][2], B0[2][2], B1[2][2];
    const char* cA = (const char*)g.A + (size_t)cur.pm * tstepA; const char* cB = (const char*)g.Bt + (size_t)cur.pn * tstepB;
    if constexpr (SP2) {
    PG8_STAGE(PG8_SB(0, 0), cB, voffB); PG8_STAGE(PG8_SB(0, 1), cB + hstepB, voffB); PG8_STAGE(PG8_SA(0, 0), cA, voffA); PG8_STAGE(PG8_SA(0, 1), cA + hstepA, voffA);
    if (wr == 1) PG8_BAR;
    PG8_WAIT_V(2); PG8_BAR;
    PG8_STAGE(PG8_SB(1, 0), cB + kstep, voffB); PG8_STAGE(PG8_SA(1, 0), cA + kstep, voffA); PG8_STAGE(PG8_SB(1, 1), cB + hstepB + kstep, voffB);
    PG8_WAIT_V(6); PG8_BAR;
    } else {
    PG8_STAGE(PG8_SB(0, 0), cB, voffB); PG8_STAGE(PG8_SA(0, 0), cA, voffA); PG8_STAGE(PG8_SB(0, 1), cB + hstepB, voffB); PG8_STAGE(PG8_SA(0, 1), cA + hstepA, voffA);
    if (wr == 1) PG8_BAR;
    PG8_WAIT_V(4); PG8_BAR;
    PG8_STAGE(PG8_SB(1, 0), cB + kstep, voffB); PG8_STAGE(PG8_SA(1, 0), cA + kstep, voffA); PG8_STAGE(PG8_SB(1, 1), cB + hstepB + kstep, voffB);
    PG8_WAIT_V(6); PG8_BAR;
    }
    for (;;) {
        const bool has_next = S.next(ui + 1, nxt);
        const char* nA = has_next ? (const char*)g.A + (size_t)nxt.pm * tstepA : cA; const char* nB = has_next ? (const char*)g.Bt + (size_t)nxt.pn * tstepB : cB;
        for (int t = 0; t < nt; t += 2) {
            const bool last = (t == nt - 2);
            const char* a1 = cA + (size_t)(t + 1) * kstep;
            const char* a2 = last ? nA : cA + (size_t)(t + 2) * kstep; const char* b2 = last ? nB : cB + (size_t)(t + 2) * kstep;
            const char* a3 = a2 + kstep; const char* b3 = b2 + kstep;
            if constexpr (!SP2) {
            PG8_LDB(B0, 0, 0); PG8_SCHED; PG8_LDA(At, 0, 0); PG8_STAGE(PG8_SA(1, 1), a1 + hstepA, voffA);
            PG8_WAIT_L(8); PG8_BAR; PG8_WAIT_L(0); PG8_MMA(0, 0, At, B0); PG8_BAR; PG8_SCHED;
            PG8_LDB(B1, 0, 1); PG8_STAGE(PG8_SB(0, 0), b2, voffB);
            PG8_BAR; PG8_WAIT_L(0); PG8_MMA(0, 1, At, B1); PG8_BAR;
            PG8_LDA(At, 0, 1); PG8_STAGE(PG8_SA(0, 0), a2, voffA);
            PG8_BAR; PG8_WAIT_L(0); PG8_MMA(1, 0, At, B0); PG8_BAR; PG8_SCHED;
            PG8_STAGE(PG8_SB(0, 1), b2 + hstepB, voffB);
            PG8_WAIT_V(6); PG8_BAR; PG8_MMA(1, 1, At, B1); PG8_BAR;
            PG8_LDB(B0, 1, 0); PG8_SCHED; PG8_LDA(At, 1, 0); PG8_STAGE(PG8_SA(0, 1), a2 + hstepA, voffA);
            PG8_WAIT_L(8); PG8_BAR; PG8_WAIT_L(0); PG8_MMA(0, 0, At, B0); PG8_BAR; PG8_SCHED;
            PG8_LDB(B1, 1, 1); PG8_STAGE(PG8_SB(1, 0), b3, voffB);
            PG8_BAR; PG8_WAIT_L(0); PG8_MMA(0, 1, At, B1); PG8_BAR;
            PG8_LDA(At, 1, 1); PG8_STAGE(PG8_SA(1, 0), a3, voffA);
            PG8_BAR; PG8_WAIT_L(0); PG8_MMA(1, 0, At, B0); PG8_BAR; PG8_SCHED;
            PG8_STAGE(PG8_SB(1, 1), b3 + hstepB, voffB);
            PG8_WAIT_V(6); PG8_BAR; PG8_MMA(1, 1, At, B1); PG8_BAR;
            } else {
            PG8_LDB(B0, 0, 0); PG8_LDB(B1, 0, 1); PG8_SCHED; PG8_LDA(At, 0, 0); PG8_STAGE(PG8_SA(1, 1), a1 + hstepA, voffA);
            PG8_WAIT_V(8); PG8_WAIT_L(0); PG8_BAR; PG8_MMA(0, 0, At, B0); PG8_MMA(0, 1, At, B1); PG8_BAR; PG8_SCHED;
            PG8_LDA(At, 0, 1); PG8_STAGE(PG8_SB(0, 0), b2, voffB); PG8_STAGE(PG8_SB(0, 1), b2 + hstepB, voffB); PG8_STAGE(PG8_SA(0, 0), a2, voffA);
            PG8_WAIT_V(8); PG8_WAIT_L(0); PG8_BAR; PG8_MMA(1, 0, At, B0); PG8_MMA(1, 1, At, B1); PG8_BAR; PG8_SCHED;
            PG8_LDB(B0, 1, 0); PG8_LDB(B1, 1, 1); PG8_SCHED; PG8_LDA(At, 1, 0); PG8_STAGE(PG8_SA(0, 1), a2 + hstepA, voffA);
            PG8_WAIT_V(8); PG8_WAIT_L(0); PG8_BAR; PG8_MMA(0, 0, At, B0); PG8_MMA(0, 1, At, B1); PG8_BAR; PG8_SCHED;
            PG8_LDA(At, 1, 1); PG8_STAGE(PG8_SB(1, 0), b3, voffB); PG8_STAGE(PG8_SB(1, 1), b3 + hstepB, voffB); PG8_STAGE(PG8_SA(1, 0), a3, voffA);
            PG8_WAIT_V(8); PG8_WAIT_L(0); PG8_BAR; PG8_MMA(1, 0, At, B0); PG8_MMA(1, 1, At, B1); PG8_BAR; PG8_SCHED;
            }
        }
        if (wr == 0) PG8_BAR;
        E(acc, cur, wr, wc, fr, fq);
        if (!has_next) break;
#pragma unroll
        for (int a = 0; a < 2; ++a)
#pragma unroll
            for (int b = 0; b < 2; ++b)
#pragma unroll
                for (int m = 0; m < 4; ++m)
#pragma unroll
                    for (int n = 0; n < 2; ++n) acc[a][b][m][n] = (f32x4){0.f, 0.f, 0.f, 0.f};
        cur = nxt; cA = nA; cB = nB; ++ui;
        if (wr == 1) PG8_BAR;
    }
    PG8_WAIT_V(0);
    PG8_BAR;
#undef PG8_SA
#undef PG8_SB
#undef PG8_STAGE
#undef PG8_LDA
#undef PG8_LDB
#undef PG8_MMA
#undef PG8_WAIT_V
#undef PG8_WAIT_L
#undef PG8_BAR
#undef PG8_SCHED
}
}

struct Params {
    const float* in[34];
    float* out;
    unsigned char* ws;
};

DI int rowmap(int mode, int n) {
    if (mode == 0) return n;
    if (mode == 1) {
        if (n < 1024) return n;
        if (n < 1088) return 4096 + (n - 1024);
        if (n < 2112) return 1024 + (n - 1088);
        if (n < 3136) return 2048 + (n - 2112);
        if (n < 3152) return 4096 + 64 + (n - 3136);
        return 3072 + (n - 3152);
    }
    if (mode == 2) return (n >> 7) * 256 + (n & 127);
    return (n >> 7) * 256 + 128 + (n & 127);
}
DI void transpose_item(const float* __restrict__ W, int K, int N, bf16_t* WT, int mode, LAS float* scr, int item, int lane, const float* kscale = nullptr) {
    const int nblk = (N + 31) >> 5, kb = item / nblk, nb = item - kb * nblk, k0 = 64 * kb, n0 = 32 * nb;
    const int r8 = lane >> 3, c4 = (lane & 7) * 4;
    const bool okl = n0 + c4 < N;
    f32x4 v[8];
    const float* src = W + (size_t)(k0 + r8) * N + n0 + c4;
#pragma unroll
    for (int i = 0; i < 8; ++i) v[i] = okl ? *(const f32x4*)(src + (size_t)(8 * i) * N) : (f32x4){0.f, 0.f, 0.f, 0.f};
    if (kscale) {
#pragma unroll
        for (int i = 0; i < 8; ++i) v[i] = v[i] * kscale[k0 + r8 + 8 * i];
    }
#pragma unroll
    for (int i = 0; i < 8; ++i) { LAS float* d = scr + (r8 + 8 * i) * 33 + c4; d[0] = v[i].x; d[1] = v[i].y; d[2] = v[i].z; d[3] = v[i].w; }
    LDS_WAIT();
    const int c = lane & 7;
#pragma unroll
    for (int j = 0; j < 4; ++j) { const int n = (lane >> 3) + 8 * j; const LAS float* s = scr + (8 * c) * 33 + n;
        u32x4 o; o.x = pk2(s[0 * 33], s[1 * 33]); o.y = pk2(s[2 * 33], s[3 * 33]); o.z = pk2(s[4 * 33], s[5 * 33]); o.w = pk2(s[6 * 33], s[7 * 33]);
        if (n0 + n < N) *(u32x4*)(WT + (size_t)rowmap(mode, n0 + n) * K + k0 + 8 * c) = o; }
    LDS_WAIT();
}
DI void rms_row_bf16(const float* xrow, const float* g, bf16_t* orow, int lane) {
    const f32x4* xr = (const f32x4*)xrow + lane; const f32x4* gr = (const f32x4*)g + lane;
    f32x4 v[8]; float s = 0.f;
#pragma unroll
    for (int j = 0; j < 8; ++j) { v[j] = xr[64 * j]; s += (v[j].x * v[j].x + v[j].y * v[j].y) + (v[j].z * v[j].z + v[j].w * v[j].w); }
    const float rstd = 1.f / sqrtf(wave_sum(s) * (1.f / DM) + RMS_EPS);
    u32x2* o8 = (u32x2*)orow + lane;
#pragma unroll
    for (int j = 0; j < 8; ++j) { const f32x4 gg = gr[64 * j]; u32x2 w; w.x = pk2(v[j].x * rstd * gg.x, v[j].y * rstd * gg.y); w.y = pk2(v[j].z * rstd * gg.z, v[j].w * rstd * gg.w); o8[64 * j] = w; }
}
DI void rms_rows_phase(const float* src, const float* g, bf16_t* dst, int gw, int ngw, int lane) {
    const f32x4* gr = (const f32x4*)g + lane;
    for (int m = gw; m < NTOK; m += 2 * ngw) {
        const int m2 = (m + ngw < NTOK) ? m + ngw : m;
        const f32x4* xa = (const f32x4*)(src + (size_t)m * DM) + lane; const f32x4* xb = (const f32x4*)(src + (size_t)m2 * DM) + lane;
        f32x4 va[8], vb[8]; float sa = 0.f, sb = 0.f;
#pragma unroll
        for (int j = 0; j < 8; ++j) va[j] = xa[64 * j];
#pragma unroll
        for (int j = 0; j < 8; ++j) vb[j] = xb[64 * j];
#pragma unroll
        for (int j = 0; j < 8; ++j) { sa += (va[j].x * va[j].x + va[j].y * va[j].y) + (va[j].z * va[j].z + va[j].w * va[j].w); sb += (vb[j].x * vb[j].x + vb[j].y * vb[j].y) + (vb[j].z * vb[j].z + vb[j].w * vb[j].w); }
        const float ra = 1.f / sqrtf(wave_sum(sa) * (1.f / DM) + RMS_EPS), rb = 1.f / sqrtf(wave_sum(sb) * (1.f / DM) + RMS_EPS);
        u32x2* oa = (u32x2*)(dst + (size_t)m * DM) + lane; u32x2* ob = (u32x2*)(dst + (size_t)m2 * DM) + lane;
#pragma unroll
        for (int j = 0; j < 8; ++j) { const f32x4 gg = gr[64 * j]; u32x2 w;
            w.x = pk2(va[j].x * ra * gg.x, va[j].y * ra * gg.y); w.y = pk2(va[j].z * ra * gg.z, va[j].w * ra * gg.w); oa[64 * j] = w;
            w.x = pk2(vb[j].x * rb * gg.x, vb[j].y * rb * gg.y); w.y = pk2(vb[j].z * rb * gg.z, vb[j].w * rb * gg.w); ob[64 * j] = w; }
    }
}
DI void final_norm_phase(float* h, const float* g, const float* ss, int gw, int ngw, int lane) {
    const f32x4* gr = (const f32x4*)g + lane;
    for (int m = gw; m < NTOK; m += 2 * ngw) {
        const int m2 = m + ngw; const bool has2 = m2 < NTOK;
        f32x4* xa = (f32x4*)(h + (size_t)m * DM) + lane; f32x4* xb = (f32x4*)(h + (size_t)(has2 ? m2 : m) * DM) + lane;
        f32x4 va[8], vb[8];
#pragma unroll
        for (int j = 0; j < 8; ++j) va[j] = xa[64 * j];
#pragma unroll
        for (int j = 0; j < 8; ++j) vb[j] = xb[64 * j];
        const float ra = 1.f / sqrtf(ss[m] * (1.f / DM) + RMS_EPS), rb = 1.f / sqrtf(ss[has2 ? m2 : m] * (1.f / DM) + RMS_EPS);
#pragma unroll
        for (int j = 0; j < 8; ++j) { const f32x4 gg = gr[64 * j]; xa[64 * j] = va[j] * ra * gg; if (has2) xb[64 * j] = vb[j] * rb * gg; }
    }
}

DI void p0_prologue(const Params& P, LAS unsigned char* lds, int gw, int ngw, int wave, int lane) {
    LAS float* scr = (LAS float*)(lds + wave * 16384);
    unsigned char* ws = P.ws;
    constexpr int I_IN0 = 32 * 131, I_UQ = 8 * 48, I_UKV = 8 * 64, I_OUT = 32 * 64, I_GU = 32 * 176, I_DN = 88 * 64, I_IN1 = 32 * 128, I_GLU = 16 * 32;
    constexpr int NITEMS = I_IN0 + I_UQ + I_UKV + 2 * I_OUT + 4 * I_GU + 2 * I_DN + I_IN1 + I_GLU;
    constexpr size_t FW = (size_t)DM * FFH;
    for (int it = gw; it < NITEMS; it += ngw) {
        int r = it;
        if (r < I_GU) { transpose_item(P.in[5], DM, FFH, (bf16_t*)(ws + WS_WGU0), 2, scr, r, lane, P.in[3]); continue; } r -= I_GU;
        if (r < I_GU) { transpose_item(P.in[6], DM, FFH, (bf16_t*)(ws + WS_WGU0), 3, scr, r, lane, P.in[3]); continue; } r -= I_GU;
        if (r < I_DN) { transpose_item(P.in[7], FFH, DM, (bf16_t*)(ws + WS_WDN0), 0, scr, r, lane); continue; } r -= I_DN;
        if (r < I_GU) { transpose_item(P.in[5] + FW, DM, FFH, (bf16_t*)(ws + WS_WGU1), 2, scr, r, lane, P.in[3] + DM); continue; } r -= I_GU;
        if (r < I_GU) { transpose_item(P.in[6] + FW, DM, FFH, (bf16_t*)(ws + WS_WGU1), 3, scr, r, lane, P.in[3] + DM); continue; } r -= I_GU;
        if (r < I_DN) { transpose_item(P.in[7] + FW, FFH, DM, (bf16_t*)(ws + WS_WDN1), 0, scr, r, lane); continue; } r -= I_DN;
        if (r < I_IN0) { transpose_item(P.in[8], DM, 4176, (bf16_t*)(ws + WS_WIN0), 1, scr, r, lane); continue; } r -= I_IN0;
        if (r < I_UQ) { transpose_item(P.in[10], 512, 1536, (bf16_t*)(ws + WS_WUQ), 0, scr, r, lane); continue; } r -= I_UQ;
        if (r < I_UKV) { transpose_item(P.in[12], 512, 2048, (bf16_t*)(ws + WS_WUKV), 0, scr, r, lane); continue; } r -= I_UKV;
        if (r < I_OUT) { transpose_item(P.in[16], DM, DM, (bf16_t*)(ws + WS_WOUT0), 0, scr, r, lane); continue; } r -= I_OUT;
        if (r < I_IN1) { transpose_item(P.in[17], DM, 4096, (bf16_t*)(ws + WS_WIN1), 0, scr, r, lane, P.in[2] + DM); continue; } r -= I_IN1;
        if (r < I_GLU) { transpose_item(P.in[26], 1024, 1024, (bf16_t*)(ws + WS_WGLU), 0, scr, r, lane); continue; } r -= I_GLU;
        transpose_item(P.in[33], DM, DM, (bf16_t*)(ws + WS_WOUT1), 0, scr, r, lane);
    }
    { u32x4* z = (u32x4*)(ws + WS_WIN0 + (size_t)(4096 + 80) * 2048 * 2); const int n16 = (NIN0 - 4096 - 80) * 2048 * 2 / 16;
      for (int i = gw * 64 + lane; i < n16; i += ngw * 64) z[i] = (u32x4){0u, 0u, 0u, 0u}; }
    { float* ssz = (float*)(ws + WS_SS); for (int i = gw * 64 + lane; i < 4 * NTOK; i += ngw * 64) ssz[i] = 0.f; }
    rms_rows_phase(P.in[0], P.in[2], (bf16_t*)(ws + WS_HN), gw, ngw, lane);
}

DI void p2_rowpass(const Params& P, int gw, int ngw, int lane) {
    bf16_t* proj = (bf16_t*)(P.ws + WS_PROJ); bf16_t* small = (bf16_t*)(P.ws + WS_SMALL);
    const int* pos = (const int*)P.in[1];
    for (int m = gw; m < NTOK; m += ngw) {
#pragma unroll
        for (int part = 0; part < 2; ++part) {
            u32x4* p = (u32x4*)(proj + (size_t)m * PROJ_LD + part * 512) + lane;
            const u32x4 w = *p; float f[8] = {bflo(w.x), bfhi(w.x), bflo(w.y), bfhi(w.y), bflo(w.z), bfhi(w.z), bflo(w.w), bfhi(w.w)};
            float s = 0.f;
#pragma unroll
            for (int j = 0; j < 8; ++j) s += f[j] * f[j];
            const float rstd = 1.f / sqrtf(wave_sum(s) * (1.f / 512.f) + RMS_EPS);
            const float* g = (part == 0 ? P.in[9] : P.in[11]) + lane * 8;
            const f32x4 g0 = *(const f32x4*)g, g1 = *(const f32x4*)(g + 4);
            u32x4 o; o.x = pk2(f[0] * rstd * g0.x, f[1] * rstd * g0.y); o.y = pk2(f[2] * rstd * g0.z, f[3] * rstd * g0.w);
            o.z = pk2(f[4] * rstd * g1.x, f[5] * rstd * g1.y); o.w = pk2(f[6] * rstd * g1.z, f[7] * rstd * g1.w);
            *p = o;
        }
        {
            bf16_t* kr = small + (size_t)m * SMALL_LD;
            const int j = lane & 31;
            const float t1 = bf2f(kr[j]), t2 = bf2f(kr[j + 32]);
            const float invf = exp2f(-(float)j * (13.287712379549449f / 32.f));
            const float ang = (float)pos[m] * invf;
            float sn, cs; sincosf(ang, &sn, &cs);
            if (lane < 32) { kr[j] = f2bf(t1 * cs - t2 * sn); kr[j + 32] = f2bf(t2 * cs + t1 * sn);
                float* tab = (float*)((unsigned char*)P.out + ((size_t)32 << 20)) + (size_t)m * 64; tab[j] = cs; tab[32 + j] = sn; }
        }
    }
}

#define DPPF(x, ctrl) __builtin_bit_cast(float, __builtin_amdgcn_update_dpp(0, __builtin_bit_cast(int, (x)), (ctrl), 0xF, 0xF, true))
template <int DQK, bool ALIBI, bool MLA>
DI void flash_unit(int wv, LAS unsigned char* lds, const bf16x8 (&qf)[DQK / 16],
                   const bf16_t* Kp, int kpitch, const bf16_t* K2p, int k2pitch, const bf16_t* Vp, int vpitch,
                   const int* posb, int q0, int posq, float slope_l2, f32x16 (&o)[4]) {
    constexpr int KP = (DQK + 8) * 2, VPB = 320, KOFF = 0, VOFF = 64 * KP, POSOFF = VOFF + 64 * VPB, STATOFF = POSOFF + 256, BUFSZ = STATOFF + 64;
    constexpr bool REV = ALIBI;
    constexpr int CPR = DQK / 8;
    constexpr int NKC = 64 * CPR / 512;
    const int tid_ = tid_from_wave(wv);
    const int tid = tid_, lane = tid & 63, r32 = lane & 31, hi = lane >> 5;
    const int wid = __builtin_amdgcn_readfirstlane(tid >> 6);
    const int NT = (q0 + 256) / 64;
    const int qw0 = q0 + 32 * wid, qrow = qw0 + r32;
    u32x4 kreg[NKC], vreg[2]; int preg = 0;
    unsigned koff[NKC]; const unsigned voff0 = (unsigned)((tid >> 4) * vpitch + 8 * (tid & 15));
#pragma unroll
    for (int i_ = 0; i_ < NKC; ++i_) { const int c_ = tid + 512 * i_, key_ = c_ / CPR, ch_ = c_ - key_ * CPR;
        koff[i_] = (MLA && ch_ >= 16) ? (unsigned)(key_ * k2pitch + 8 * (ch_ - 16)) : (unsigned)(key_ * kpitch + 8 * ch_); }
#define FL_GLOAD(t) do { const bf16_t* kt_ = Kp + (size_t)(64 * (t)) * kpitch; const bf16_t* k2t_ = MLA ? K2p + (size_t)(64 * (t)) * k2pitch : Kp; const bf16_t* vt_ = Vp + (size_t)(64 * (t)) * vpitch; \
        _Pragma("unroll") for (int i_ = 0; i_ < NKC; ++i_) { const int c_ = tid + 512 * i_, key_ = c_ / CPR, ch_ = c_ - key_ * CPR; \
            if (MLA) kreg[i_] = (ch_ < 16) ? *(const u32x4*)(kt_ + koff[i_]) : *(const u32x4*)(k2t_ + koff[i_]); \
            else kreg[i_] = *(const u32x4*)(kt_ + koff[i_]); } \
        vreg[0] = *(const u32x4*)(vt_ + voff0); vreg[1] = *(const u32x4*)(vt_ + (size_t)32 * vpitch + voff0); \
        if (ALIBI) { if (tid < 64) preg = (posb + 64 * (t))[tid]; } } while (0)
#define FL_LSTORE(buf) do { LAS unsigned char* b_ = lds + (buf) * BUFSZ; \
        _Pragma("unroll") for (int i_ = 0; i_ < NKC; ++i_) { const int c_ = tid + 512 * i_, key_ = c_ / CPR, ch_ = c_ - key_ * CPR; *(LAS u32x4*)(b_ + KOFF + key_ * KP + ch_ * 16) = kreg[i_]; } \
        _Pragma("unroll") for (int i_ = 0; i_ < 2; ++i_) { const int c_ = tid + 512 * i_, key_ = c_ >> 4, ch_ = c_ & 15; *(LAS u32x4*)(b_ + VOFF + key_ * VPB + ch_ * 16) = vreg[i_]; } \
        if (ALIBI) { if (tid < 64) *(LAS int*)(b_ + POSOFF + 4 * tid) = preg; \
              \
            { const u32x4 w_ = kreg[0]; float a0_ = bflo(w_.x), a1_ = bfhi(w_.x), a2_ = bflo(w_.y), a3_ = bfhi(w_.y), a4_ = bflo(w_.z), a5_ = bfhi(w_.z), a6_ = bflo(w_.w), a7_ = bfhi(w_.w); \
              float q_ = (a0_ * a0_ + a1_ * a1_) + (a2_ * a2_ + a3_ * a3_) + (a4_ * a4_ + a5_ * a5_) + (a6_ * a6_ + a7_ * a7_); \
              q_ += DPPF(q_, 0xB1); q_ += DPPF(q_, 0x4E); q_ += DPPF(q_, 0x141); q_ = fmaxf(q_, DPPF(q_, 0x140)); \
              q_ = fmaxf(q_, __shfl_xor(q_, 16)); q_ = fmaxf(q_, __shfl_xor(q_, 32)); \
              if (lane == 0) *(LAS float*)(b_ + STATOFF + 4 * wid) = q_; } \
            if (tid < 64) { int mn_ = preg, mx_ = preg; \
              _Pragma("unroll") for (int o_ = 1; o_ < 64; o_ <<= 1) { const int a_ = __shfl_xor(mn_, o_), c_ = __shfl_xor(mx_, o_); mn_ = a_ < mn_ ? a_ : mn_; mx_ = c_ > mx_ ? c_ : mx_; } \
              if (tid == 0) { *(LAS int*)(b_ + STATOFF + 32) = mn_; *(LAS int*)(b_ + STATOFF + 36) = mx_; } } } } while (0)
    float mrun = -INFINITY, lrun = 0.f;
#pragma unroll
    for (int d = 0; d < 4; ++d)
#pragma unroll
        for (int r = 0; r < 16; ++r) o[d][r] = 0.f;
    float qn = 0.f;
    if (ALIBI) {
#pragma unroll
        for (int s = 0; s < DQK / 16; ++s) { const u32x4 w = __builtin_bit_cast(u32x4, qf[s]);
            qn += (bflo(w.x) * bflo(w.x) + bfhi(w.x) * bfhi(w.x)) + (bflo(w.y) * bflo(w.y) + bfhi(w.y) * bfhi(w.y)) + (bflo(w.z) * bflo(w.z) + bfhi(w.z) * bfhi(w.z)) + (bflo(w.w) * bflo(w.w) + bfhi(w.w) * bfhi(w.w)); }
        qn += __shfl_xor(qn, 32);
        qn = sqrtf(qn) * 1.02f;
    }
    FL_GLOAD(REV ? NT - 1 : 0); FL_LSTORE(0);
    __syncthreads();
    const int i16 = lane & 15, g16 = (lane >> 4) & 1;
    for (int it = 0; it < NT; ++it) {
        const int t = REV ? NT - 1 - it : it;
        const int buf = it & 1;
        if (it + 1 < NT) FL_GLOAD(REV ? t - 1 : t + 1);
        bool skip = false;
        if (ALIBI) {
            const LAS unsigned char* sb = lds + buf * BUFSZ + STATOFF;
            const f32x4 s0 = *(const LAS f32x4*)sb, s1 = *(const LAS f32x4*)(sb + 16);
            const float k2 = fmaxf(fmaxf(fmaxf(s0.x, s0.y), fmaxf(s0.z, s0.w)), fmaxf(fmaxf(s1.x, s1.y), fmaxf(s1.z, s1.w)));
            const int pmn = *(const LAS int*)(sb + 32), pmx = *(const LAS int*)(sb + 36);
            int dm = posq - pmx; const int dm2 = pmn - posq; dm = dm > dm2 ? dm : dm2; dm = dm > 0 ? dm : 0;
            const bool c = (qn * sqrtf(k2) * 1.02f - slope_l2 * (float)dm - mrun) < -40.f;
            skip = __all(c) != 0;
        }
        if (64 * t <= qw0 + 31 && !skip) {
            const LAS unsigned char* kb = lds + buf * BUFSZ + KOFF + r32 * KP + hi * 16;
            f32x16 p0, p1;
#pragma unroll
            for (int r = 0; r < 16; ++r) { p0[r] = 0.f; p1[r] = 0.f; }
#pragma unroll
            for (int s = 0; s < DQK / 16; ++s) {
                const bf16x8 a0 = *(const LAS bf16x8*)(kb + s * 32), a1 = *(const LAS bf16x8*)(kb + 32 * KP + s * 32);
                p0 = MFMA32(a0, qf[s], p0); p1 = MFMA32(a1, qf[s], p1);
                if ((s & 3) == 3) __builtin_amdgcn_sched_barrier(0);
            }
            if (ALIBI) {
                const LAS unsigned char* pb = lds + buf * BUFSZ + POSOFF;
#pragma unroll
                for (int g = 0; g < 4; ++g) {
                    const i32x4 k0 = *(const LAS i32x4*)(pb + (8 * g + 4 * hi) * 4), k1 = *(const LAS i32x4*)(pb + (32 + 8 * g + 4 * hi) * 4);
#pragma unroll
                    for (int j = 0; j < 4; ++j) {
                        int d0 = posq - k0[j]; d0 = d0 < 0 ? -d0 : d0; int d1 = posq - k1[j]; d1 = d1 < 0 ? -d1 : d1;
                        p0[4 * g + j] -= slope_l2 * (float)d0; p1[4 * g + j] -= slope_l2 * (float)d1;
                    }
                }
            }
            if (64 * t + 63 > qw0) {
#pragma unroll
                for (int r = 0; r < 16; ++r) { const int key = 64 * t + crow(r, hi); if (key > qrow) p0[r] = -INFINITY; if (key + 32 > qrow) p1[r] = -INFINITY; }
            }
            float rm = fmaxf(p0[0], p1[0]);
#pragma unroll
            for (int r = 1; r < 16; ++r) rm = fmaxf(rm, fmaxf(p0[r], p1[r]));
            rm = fmaxf(rm, __shfl_xor(rm, 32));
            const float mnew = fmaxf(mrun, rm);
            if (__any(mnew > mrun)) {
                const float alpha = __builtin_amdgcn_exp2f(mrun - mnew);
                lrun *= alpha;
#pragma unroll
                for (int d = 0; d < 4; ++d)
#pragma unroll
                    for (int r = 0; r < 16; ++r) o[d][r] *= alpha;
            }
            mrun = mnew;
            float ps = 0.f;
#pragma unroll
            for (int r = 0; r < 16; ++r) { p0[r] = __builtin_amdgcn_exp2f(p0[r] - mnew); p1[r] = __builtin_amdgcn_exp2f(p1[r] - mnew); ps += p0[r] + p1[r]; }
            lrun += ps;
            bf16x8 pf[4];
            { u32x4 w;
              w.x = pk2(p0[0], p0[1]); w.y = pk2(p0[2], p0[3]); w.z = pk2(p0[4], p0[5]); w.w = pk2(p0[6], p0[7]); pf[0] = __builtin_bit_cast(bf16x8, w);
              w.x = pk2(p0[8], p0[9]); w.y = pk2(p0[10], p0[11]); w.z = pk2(p0[12], p0[13]); w.w = pk2(p0[14], p0[15]); pf[1] = __builtin_bit_cast(bf16x8, w);
              w.x = pk2(p1[0], p1[1]); w.y = pk2(p1[2], p1[3]); w.z = pk2(p1[4], p1[5]); w.w = pk2(p1[6], p1[7]); pf[2] = __builtin_bit_cast(bf16x8, w);
              w.x = pk2(p1[8], p1[9]); w.y = pk2(p1[10], p1[11]); w.z = pk2(p1[12], p1[13]); w.w = pk2(p1[14], p1[15]); pf[3] = __builtin_bit_cast(bf16x8, w); }
            const LAS unsigned char* vb = lds + buf * BUFSZ + VOFF + (4 * hi + (i16 >> 2)) * VPB + (16 * g16 + 4 * (i16 & 3)) * 2;
#pragma unroll
            for (int d = 0; d < 4; ++d)
#pragma unroll
                for (int s = 0; s < 4; ++s) {
                    const s16x4 lo = tr_read(vb + (16 * s) * VPB + d * 64), hh = tr_read(vb + (16 * s + 8) * VPB + d * 64);
                    o[d] = MFMA32(cat8(lo, hh), pf[s], o[d]);
                }
        }
        if (it + 1 < NT) FL_LSTORE(buf ^ 1);
        __syncthreads();
    }
    lrun += __shfl_xor(lrun, 32);
    const float il = 1.f / lrun;
#pragma unroll
    for (int d = 0; d < 4; ++d)
#pragma unroll
        for (int r = 0; r < 16; ++r) o[d][r] *= il;
#undef FL_GLOAD
#undef FL_LSTORE
}

DI void mla_unit(int wv, const Params& P, LAS unsigned char* lds, int u) {
    const int qb = 7 - (u >> 6), bh = u & 63, b = bh >> 3, h = bh & 7;
    const int tid_ = tid_from_wave(wv);
    const int tid = tid_, lane = tid & 63, r32 = lane & 31, hi = lane >> 5;
    const int wid = __builtin_amdgcn_readfirstlane(tid >> 6);
    const int q0 = 256 * qb, qrow = q0 + 32 * wid + r32;
    const size_t tok = (size_t)b * SEQ + qrow;
    const bf16_t* Q = (const bf16_t*)(P.ws + WS_Q); const bf16_t* KV = (const bf16_t*)(P.ws + WS_KV); const bf16_t* SM = (const bf16_t*)(P.ws + WS_SMALL);
    bf16_t* MIX = (bf16_t*)(P.ws + WS_HN);
    const int* pos = (const int*)P.in[1];
    const float qscale = 0.07216878364870322f * LOG2E;
    bf16x8 qf[12];
    const bf16_t* qp = Q + tok * Q_LD + h * 192 + 8 * hi;
#pragma unroll
    for (int s = 0; s < 8; ++s) {
        const u32x4 w = *(const u32x4*)(qp + 16 * s);
        u32x4 o; o.x = pk2(bflo(w.x) * qscale, bfhi(w.x) * qscale); o.y = pk2(bflo(w.y) * qscale, bfhi(w.y) * qscale);
        o.z = pk2(bflo(w.z) * qscale, bfhi(w.z) * qscale); o.w = pk2(bflo(w.w) * qscale, bfhi(w.w) * qscale);
        qf[s] = __builtin_bit_cast(bf16x8, o);
    }
#pragma unroll
    for (int s = 0; s < 2; ++s) {
        const u32x4 w1 = *(const u32x4*)(qp + 16 * (8 + s)), w2 = *(const u32x4*)(qp + 16 * (10 + s));
        float t1[8] = {bflo(w1.x), bfhi(w1.x), bflo(w1.y), bfhi(w1.y), bflo(w1.z), bfhi(w1.z), bflo(w1.w), bfhi(w1.w)};
        float t2[8] = {bflo(w2.x), bfhi(w2.x), bflo(w2.y), bfhi(w2.y), bflo(w2.z), bfhi(w2.z), bflo(w2.w), bfhi(w2.w)};
        float o1[8], o2[8];
        const float* tab = (const float*)((const unsigned char*)P.out + ((size_t)32 << 20)) + tok * 64 + 16 * s + 8 * hi;
        const f32x4 c0 = *(const f32x4*)tab, c1 = *(const f32x4*)(tab + 4), s0 = *(const f32x4*)(tab + 32), s1 = *(const f32x4*)(tab + 36);
        const float csv[8] = {c0.x, c0.y, c0.z, c0.w, c1.x, c1.y, c1.z, c1.w}, snv[8] = {s0.x, s0.y, s0.z, s0.w, s1.x, s1.y, s1.z, s1.w};
#pragma unroll
        for (int jj = 0; jj < 8; ++jj) {
            const float cs = csv[jj], sn = snv[jj];
            o1[jj] = (t1[jj] * cs - t2[jj] * sn) * qscale; o2[jj] = (t2[jj] * cs + t1[jj] * sn) * qscale;
        }
        u32x4 a, c; a.x = pk2(o1[0], o1[1]); a.y = pk2(o1[2], o1[3]); a.z = pk2(o1[4], o1[5]); a.w = pk2(o1[6], o1[7]);
        c.x = pk2(o2[0], o2[1]); c.y = pk2(o2[2], o2[3]); c.z = pk2(o2[4], o2[5]); c.w = pk2(o2[6], o2[7]);
        qf[8 + s] = __builtin_bit_cast(bf16x8, a); qf[10 + s] = __builtin_bit_cast(bf16x8, c);
    }
    f32x16 o[4];
    flash_unit<192, false, true>(wv, lds, qf, KV + (size_t)b * SEQ * KV_LD + h * 256, KV_LD, SM + (size_t)b * SEQ * SMALL_LD, SMALL_LD,
                                 KV + (size_t)b * SEQ * KV_LD + h * 256 + 128, KV_LD, nullptr, q0, 0, 0.f, o);
    bf16_t* op = MIX + tok * DM + h * 128;
#pragma unroll
    for (int d = 0; d < 4; ++d)
#pragma unroll
        for (int g = 0; g < 4; ++g) { u32x2 w; w.x = pk2(o[d][4 * g], o[d][4 * g + 1]); w.y = pk2(o[d][4 * g + 2], o[d][4 * g + 3]); *(u32x2*)(op + 32 * d + 8 * g + 4 * hi) = w; }
}

DI void diff_unit(int wv, const Params& P, LAS unsigned char* lds, int u) {
    const int qb = 7 - (u >> 6), bh = u & 63, b = bh >> 3, h = bh & 7;
    const int tid_ = tid_from_wave(wv);
    const int tid = tid_, lane = tid & 63, r32 = lane & 31, hi = lane >> 5;
    const int wid = __builtin_amdgcn_readfirstlane(tid >> 6);
    const int q0 = 256 * qb, qrow = q0 + 32 * wid + r32;
    const size_t tok = (size_t)b * SEQ + qrow;
    const bf16_t* PR = (const bf16_t*)(P.ws + WS_PROJ);
    bf16_t* MIX = (bf16_t*)(P.ws + WS_HN);
    const int* pos = (const int*)P.in[1];
    const float qscale = 0.125f * LOG2E;
    const float slope_l2 = exp2f(-(float)(h + 1)) * LOG2E;
    const int posq = pos[tok];
    f32x16 o1[4], o2[4];
#pragma unroll
    for (int c = 0; c < 2; ++c) {
        bf16x8 qf[4];
        const bf16_t* qp = PR + tok * PROJ_LD + 1024 + h * 128 + c * 64 + 8 * hi;
#pragma unroll
        for (int s = 0; s < 4; ++s) {
            const u32x4 w = *(const u32x4*)(qp + 16 * s);
            u32x4 o; o.x = pk2(bflo(w.x) * qscale, bfhi(w.x) * qscale); o.y = pk2(bflo(w.y) * qscale, bfhi(w.y) * qscale);
            o.z = pk2(bflo(w.z) * qscale, bfhi(w.z) * qscale); o.w = pk2(bflo(w.w) * qscale, bfhi(w.w) * qscale);
            qf[s] = __builtin_bit_cast(bf16x8, o);
        }
        const bf16_t* kp = PR + (size_t)b * SEQ * PROJ_LD + 2048 + h * 128 + c * 64;
        const bf16_t* vp = PR + (size_t)b * SEQ * PROJ_LD + 3072 + h * 128;
        if (c == 0) {
            flash_unit<64, true, false>(wv, lds, qf, kp, PROJ_LD, nullptr, 0, vp, PROJ_LD, pos + (size_t)b * SEQ, q0, posq, slope_l2, o1);
            LAS float* sv = (LAS float*)(lds + 60160) + tid;
#pragma unroll
            for (int r = 0; r < 16; ++r) { sv[r * 512] = o1[2][r]; sv[(16 + r) * 512] = o1[3][r]; }
            sv[32 * 512] = o1[1][14]; sv[33 * 512] = o1[1][15];
        } else flash_unit<64, true, false>(wv, lds, qf, kp, PROJ_LD, nullptr, 0, vp, PROJ_LD, pos + (size_t)b * SEQ, q0, posq, slope_l2, o2);
    }
    {
        const LAS float* sv = (const LAS float*)(lds + 60160) + tid_from_wave(wv);
#pragma unroll
        for (int r = 0; r < 16; ++r) { o1[2][r] = sv[r * 512]; o1[3][r] = sv[(16 + r) * 512]; }
        o1[1][14] = sv[32 * 512]; o1[1][15] = sv[33 * 512];
    }
    const int tidb = tid_from_wave(wv), laneb = tidb & 63, hib = laneb >> 5;
    const size_t tokb = (size_t)b * SEQ + q0 + 32 * (tidb >> 6) + (laneb & 31);
    float d1 = P.in[28][laneb] * P.in[29][laneb], d2 = P.in[30][laneb] * P.in[31][laneb];
    d1 = wave_sum(d1); d2 = wave_sum(d2);
    const float lam = expf(d1) - expf(d2) + LAMBDA_INIT;
    float ss = 0.f;
#pragma unroll
    for (int d = 0; d < 4; ++d)
#pragma unroll
        for (int r = 0; r < 16; ++r) { const float v = o1[d][r] - lam * o2[d][r]; o1[d][r] = v; ss += v * v; }
    ss += __shfl_xor(ss, 32);
    const float rstd = (1.f / sqrtf(ss * (1.f / 128.f) + RMS_EPS)) * (1.f - LAMBDA_INIT);
    const float* dn = P.in[32];
    bf16_t* op = MIX + tokb * DM + 1024 + h * 128;
#pragma unroll
    for (int d = 0; d < 4; ++d)
#pragma unroll
        for (int g = 0; g < 4; ++g) { const int e = 32 * d + 8 * g + 4 * hib; const f32x4 gg = *(const f32x4*)(dn + e);
            u32x2 w; w.x = pk2(o1[d][4 * g] * rstd * gg.x, o1[d][4 * g + 1] * rstd * gg.y); w.y = pk2(o1[d][4 * g + 2] * rstd * gg.z, o1[d][4 * g + 3] * rstd * gg.w);
            *(u32x2*)(op + e) = w; }
}

constexpr size_t OUT_KH = 0;
constexpr size_t OUT_DEC = (size_t)NTOK * 512 * 2;
constexpr size_t OUT_U = OUT_DEC + (size_t)256 * 512 * 4;
constexpr size_t OUT_DSEG = OUT_U + (size_t)96 * 131072;
constexpr size_t OUT_ROPE = (size_t)32 << 20;
DI float log_sigmoid_(float x) { return fminf(x, 0.f) - __logf(1.f + __expf(-fabsf(x))); }
DI void gla_prep_item(int wv, const Params& P, LAS unsigned char* lds, int item) {
    const int tid_ = tid_from_wave(wv);
    const int tid = tid_;
    const int b = item >> 7, h = (item >> 5) & 3, ch = item & 31;
    bf16_t* PR = (bf16_t*)(P.ws + WS_PROJ); const bf16_t* SM = (const bf16_t*)(P.ws + WS_SMALL);
    bf16_t* KH = (bf16_t*)((unsigned char*)P.out + OUT_KH); float* DEC = (float*)((unsigned char*)P.out + OUT_DEC);
    LAS float* glrs = (LAS float*)lds; LAS float* tots = (LAS float*)(lds + 4096);
    const int d = tid & 127, part = tid >> 7;
    const size_t tok0 = (size_t)b * SEQ + 64 * ch;
    float wg[16];
#pragma unroll
    for (int r = 0; r < 16; ++r) wg[r] = P.in[13][r * 512 + h * 128 + d];
    const float bg = P.in[14][h * 128 + d];
    if (tid < 256) { const int tk = tid >> 2, r0 = (tid & 3) * 4; const u32x2 w = *(const u32x2*)(SM + (tok0 + tk) * SMALL_LD + 64 + r0);
        *(LAS f32x4*)(glrs + tk * 16 + r0) = (f32x4){bflo(w.x), bfhi(w.x), bflo(w.y), bfhi(w.y)}; }
    float qv[16], kv[16];
#pragma unroll
    for (int i = 0; i < 16; ++i) { const size_t a = (tok0 + 16 * part + i) * PROJ_LD + 1024 + h * 128 + d; qv[i] = bf2f(PR[a]); kv[i] = bf2f(PR[a + 512]); }
    __syncthreads();
    float cum[16]; float run = 0.f;
#pragma unroll
    for (int i = 0; i < 16; ++i) {
        const LAS f32x4* gp = (const LAS f32x4*)(glrs + (16 * part + i) * 16);
        const f32x4 g0 = gp[0], g1 = gp[1], g2 = gp[2], g3 = gp[3];
        float x = bg;
        x += g0.x * wg[0] + g0.y * wg[1] + g0.z * wg[2] + g0.w * wg[3];
        x += g1.x * wg[4] + g1.y * wg[5] + g1.z * wg[6] + g1.w * wg[7];
        x += g2.x * wg[8] + g2.y * wg[9] + g2.z * wg[10] + g2.w * wg[11];
        x += g3.x * wg[12] + g3.y * wg[13] + g3.z * wg[14] + g3.w * wg[15];
        run += log_sigmoid_(x) * (1.f / 16.f);
        cum[i] = run;
    }
    tots[part * 128 + d] = run;
    __syncthreads();
    float pre = 0.f, last = 0.f;
#pragma unroll
    for (int pp = 0; pp < 4; ++pp) { const float tv = tots[pp * 128 + d]; if (pp < part) pre += tv; last += tv; }
    if (part == 0) DEC[(size_t)(b * 32 + ch) * 512 + h * 128 + d] = __expf(last);
#pragma unroll
    for (int i = 0; i < 16; ++i) {
        const size_t tk = tok0 + 16 * part + i; const float c = cum[i] + pre;
        PR[tk * PROJ_LD + 1024 + h * 128 + d] = f2bf(qv[i] * __expf(c) * 0.08838834764831845f);
        PR[tk * PROJ_LD + 1536 + h * 128 + d] = f2bf(kv[i] * __expf(-c));
        KH[tk * 512 + h * 128 + d] = f2bf(kv[i] * __expf(last - c));
    }
    __syncthreads();
}

template <bool STATE_ONLY>
DI void gla_unit(int wv, const Params& P, LAS unsigned char* lds, int b, int h, int seg) {
    constexpr int QP = 288, VP2 = 544, PP = 144, OP = 528;
    constexpr int OFF_Q = 0, OFF_K = OFF_Q + 64 * QP, OFF_KH = OFF_K + 64 * QP, OFF_V = OFF_KH + 64 * QP, OFF_P = OFF_V + 64 * VP2;
    constexpr int OFF_DEC = OFF_P + 64 * PP, OFF_SS = OFF_DEC + 128 * 4, OFF_END = OFF_SS + 64 * 8 * 4, OFF_O = 0;
    static_assert(OFF_END <= LDS_RING && 64 * OP <= OFF_KH, "gla lds");
    const int tid_ = tid_from_wave(wv);
    const int tid = tid_, lane = tid & 63, i16 = lane & 15, quad = lane >> 4;
    const int ch0 = 8 * seg, bh = b * 4 + h;
    f32x4* UU = (f32x4*)((unsigned char*)P.out + OUT_U); float* DSEG = (float*)((unsigned char*)P.out + OUT_DSEG);
    const int wid = __builtin_amdgcn_readfirstlane(tid >> 6);
    const bf16_t* PR = (const bf16_t*)(P.ws + WS_PROJ);
    const bf16_t* KH = (const bf16_t*)((const unsigned char*)P.out + OUT_KH); const float* DEC = (const float*)((const unsigned char*)P.out + OUT_DEC);
    bf16_t* MIX = (bf16_t*)(P.ws + WS_HN);
    const int e0 = 32 * wid;
    f32x4 st[8][2];
#pragma unroll
    for (int a = 0; a < 8; ++a)
#pragma unroll
        for (int c = 0; c < 2; ++c) st[a][c] = (f32x4){0.f, 0.f, 0.f, 0.f};
    if (!STATE_ONLY) {
        for (int sg = 0; sg < seg; ++sg) {
            const f32x4* up = UU + ((size_t)(bh * 3 + sg) * 8 + wid) * 1024 + lane;
            const float* dp = DSEG + (size_t)(bh * 3 + sg) * 128 + 4 * quad;
#pragma unroll
            for (int a = 0; a < 8; ++a) { const f32x4 dc = *(const f32x4*)(dp + 16 * a);
                st[a][0] = st[a][0] * dc + up[(a * 2 + 0) * 64]; st[a][1] = st[a][1] * dc + up[(a * 2 + 1) * 64]; }
        }
    }
    float dprod = 1.f;
    const float gn0 = P.in[15][e0 + i16], gn1 = P.in[15][e0 + 16 + i16];
    LAS float* decs = (LAS float*)(lds + OFF_DEC); LAS float* sss = (LAS float*)(lds + OFF_SS);
    u32x4 rq[2], rk[2], rh[2], rv[4]; float rd = 0.f;
    const unsigned oq = (unsigned)((tid >> 4) * PROJ_LD + 8 * (tid & 15)), okh = (unsigned)((tid >> 4) * 512 + 8 * (tid & 15)), ovv = (unsigned)((tid >> 5) * PROJ_LD + 8 * (tid & 31));
    const unsigned omix = (unsigned)((tid >> 5) * DM + 8 * (tid & 31));
#define GLA_GLOAD(ch) do { const size_t t0_ = (size_t)b * SEQ + 64 * (ch); \
        _Pragma("unroll") for (int i_ = 0; i_ < 2; ++i_) { \
            const bf16_t* pq_ = PR + (t0_ + 32 * i_) * PROJ_LD + 1024 + h * 128; const bf16_t* ph_ = KH + (t0_ + 32 * i_) * 512 + h * 128; \
            if (!STATE_ONLY) { rq[i_] = *(const u32x4*)(pq_ + oq); rk[i_] = *(const u32x4*)(pq_ + 512 + oq); } rh[i_] = *(const u32x4*)(ph_ + okh); } \
        if (STATE_ONLY) { _Pragma("unroll") for (int i_ = 0; i_ < 4; ++i_) { const bf16_t* pv_ = PR + (t0_ + 16 * i_) * PROJ_LD + 2048 + h * 256; rv[i_] = *(const u32x4*)(pv_ + ovv); } } \
        if (tid < 128) rd = (DEC + (size_t)(b * 32 + (ch)) * 512 + h * 128)[tid]; } while (0)
    GLA_GLOAD(ch0);
    for (int ch = ch0; ch < ch0 + 8; ++ch) {
        const size_t tok0 = (size_t)b * SEQ + 64 * ch;
#pragma unroll
        for (int i = 0; i < 2; ++i) { const int c = tid + 512 * i, j = c >> 4, cc = c & 15;
            if (!STATE_ONLY) { *(LAS u32x4*)(lds + OFF_Q + j * QP + cc * 16) = rq[i]; *(LAS u32x4*)(lds + OFF_K + j * QP + cc * 16) = rk[i]; } *(LAS u32x4*)(lds + OFF_KH + j * QP + cc * 16) = rh[i]; }
#pragma unroll
        for (int i = 0; i < 4; ++i) { if (!STATE_ONLY) { const bf16_t* pv_ = PR + (tok0 + 16 * i) * PROJ_LD + 2048 + h * 256; rv[i] = *(const u32x4*)(pv_ + ovv); }
            else { const int c = tid + 512 * i, j = c >> 5, cc = c & 31; *(LAS u32x4*)(lds + OFF_V + j * VP2 + cc * 16) = rv[i]; } }
        if (tid < 128) { decs[tid] = rd; dprod *= rd; }
        __syncthreads();
        if (!STATE_ONLY) {
#pragma unroll
        for (int x = 0; x < 2; ++x) {
            const int tl = 2 * wid + x, it = tl >> 2, jt = tl & 3;
            f32x4 acc = (f32x4){0.f, 0.f, 0.f, 0.f};
            if (jt <= it) {
#pragma unroll
                for (int s = 0; s < 4; ++s) {
                    const bf16x8 a = *(const LAS bf16x8*)(lds + OFF_Q + (16 * it + i16) * QP + (32 * s + 8 * quad) * 2);
                    const bf16x8 bb = *(const LAS bf16x8*)(lds + OFF_K + (16 * jt + i16) * QP + (32 * s + 8 * quad) * 2);
                    acc = MFMA16(a, bb, acc);
                }
            }
#pragma unroll
            for (int r = 0; r < 4; ++r) { const int i = 16 * it + 4 * quad + r, j = 16 * jt + i16; const float v = (j <= i) ? acc[r] : 0.f;
                *(LAS bf16_t*)(lds + OFF_P + i * PP + j * 2) = f2bf(v); }
        }
        }
        if (!STATE_ONLY) {
#pragma unroll
        for (int i = 0; i < 4; ++i) { const int c = tid + 512 * i, j = c >> 5, cc = c & 31; *(LAS u32x4*)(lds + OFF_V + j * VP2 + cc * 16) = rv[i]; }
        __syncthreads();
        }
        bf16x8 vf[2][2];
#pragma unroll
        for (int s = 0; s < 2; ++s)
#pragma unroll
            for (int et = 0; et < 2; ++et) {
                const LAS unsigned char* vb = lds + OFF_V + (32 * s + 8 * quad + (i16 >> 2)) * VP2 + (e0 + 16 * et + 4 * (i16 & 3)) * 2;
                vf[s][et] = cat8(tr_read(vb), tr_read(vb + 4 * VP2));
            }
        if (!STATE_ONLY) {
        f32x4 oo[4][2];
#pragma unroll
        for (int it = 0; it < 4; ++it)
#pragma unroll
            for (int et = 0; et < 2; ++et) oo[it][et] = (f32x4){0.f, 0.f, 0.f, 0.f};
#pragma unroll
        for (int s = 0; s < 2; ++s)
#pragma unroll
            for (int it = 0; it < 4; ++it) {
                const bf16x8 a = *(const LAS bf16x8*)(lds + OFF_P + (16 * it + i16) * PP + (32 * s + 8 * quad) * 2);
                oo[it][0] = MFMA16(a, vf[s][0], oo[it][0]); oo[it][1] = MFMA16(a, vf[s][1], oo[it][1]);
                if (it == 3) __builtin_amdgcn_sched_barrier(0);
            }
#pragma unroll
        for (int s = 0; s < 4; ++s) {
            bf16x8 sb[2];
#pragma unroll
            for (int et = 0; et < 2; ++et) { u32x4 w; w.x = pk2(st[2 * s][et][0], st[2 * s][et][1]); w.y = pk2(st[2 * s][et][2], st[2 * s][et][3]);
                w.z = pk2(st[2 * s + 1][et][0], st[2 * s + 1][et][1]); w.w = pk2(st[2 * s + 1][et][2], st[2 * s + 1][et][3]); sb[et] = __builtin_bit_cast(bf16x8, w); }
#pragma unroll
            for (int it = 0; it < 4; ++it) {
                const LAS unsigned char* qa = lds + OFF_Q + (16 * it + i16) * QP + (32 * s + 4 * quad) * 2;
                const u32x2 lo = *(const LAS u32x2*)qa, hh = *(const LAS u32x2*)(qa + 32);
                const bf16x8 a = __builtin_bit_cast(bf16x8, (u32x4){lo.x, lo.y, hh.x, hh.y});
                oo[it][0] = MFMA16(a, sb[0], oo[it][0]); oo[it][1] = MFMA16(a, sb[1], oo[it][1]);
            }
            __builtin_amdgcn_sched_barrier(0);
        }
#pragma unroll
        for (int it = 0; it < 4; ++it)
#pragma unroll
            for (int r = 0; r < 4; ++r) {
                float s2 = dpp_add16(oo[it][0][r] * oo[it][0][r] + oo[it][1][r] * oo[it][1][r]);
                if (i16 == 0) sss[(16 * it + 4 * quad + r) * 8 + wid] = s2;
            }
        __syncthreads();
#pragma unroll
        for (int it = 0; it < 4; ++it)
#pragma unroll
            for (int r = 0; r < 4; ++r) {
                const int i = 16 * it + 4 * quad + r;
                const LAS f32x4* sp = (const LAS f32x4*)(sss + i * 8); const f32x4 s0 = sp[0], s1 = sp[1];
                const float tot = (s0.x + s0.y) + (s0.z + s0.w) + (s1.x + s1.y) + (s1.z + s1.w);
                const float rstd = 1.f / sqrtf(tot * (1.f / 256.f) + RMS_EPS);
                *(LAS bf16_t*)(lds + OFF_O + i * OP + (e0 + i16) * 2) = f2bf(oo[it][0][r] * rstd * gn0);
                *(LAS bf16_t*)(lds + OFF_O + i * OP + (e0 + 16 + i16) * 2) = f2bf(oo[it][1][r] * rstd * gn1);
            }
        }
        if (ch + 1 < ch0 + 8) GLA_GLOAD(ch + 1);
        u32x4 gpre[4];
        if (!STATE_ONLY) {
#pragma unroll
        for (int i = 0; i < 4; ++i) gpre[i] = *(const u32x4*)((PR + (tok0 + 16 * i) * PROJ_LD + 3072 + h * 256) + ovv);
        }
#pragma unroll
        for (int dt = 0; dt < 8; ++dt) {
            const f32x4 dc = *(const LAS f32x4*)(decs + 16 * dt + 4 * quad);
            st[dt][0] *= dc; st[dt][1] *= dc;
#pragma unroll
            for (int s = 0; s < 2; ++s) {
                const LAS unsigned char* kb = lds + OFF_KH + (32 * s + 8 * quad + (i16 >> 2)) * QP + (16 * dt + 4 * (i16 & 3)) * 2;
                const bf16x8 a = cat8(tr_read(kb), tr_read(kb + 4 * QP));
                st[dt][0] = MFMA16(a, vf[s][0], st[dt][0]); st[dt][1] = MFMA16(a, vf[s][1], st[dt][1]);
            }
            if (dt & 1) __builtin_amdgcn_sched_barrier(0);
        }
        __syncthreads();
        if (!STATE_ONLY) {
#pragma unroll
        for (int i = 0; i < 4; ++i) { const int c = tid + 512 * i, row = c >> 5, cc = c & 31;
            const u32x4 ov = *(const LAS u32x4*)(lds + OFF_O + row * OP + cc * 16);
            const u32x4 gv = gpre[i];
            u32x4 w;
            w.x = pk2(bflo(ov.x) * siluf_(bflo(gv.x)), bfhi(ov.x) * siluf_(bfhi(gv.x)));
            w.y = pk2(bflo(ov.y) * siluf_(bflo(gv.y)), bfhi(ov.y) * siluf_(bfhi(gv.y)));
            w.z = pk2(bflo(ov.z) * siluf_(bflo(gv.z)), bfhi(ov.z) * siluf_(bfhi(gv.z)));
            w.w = pk2(bflo(ov.w) * siluf_(bflo(gv.w)), bfhi(ov.w) * siluf_(bfhi(gv.w)));
            *(u32x4*)((MIX + (tok0 + 16 * i) * DM + 1024 + h * 256) + omix) = w; }
        __syncthreads();
        }
    }
    if (STATE_ONLY) {
        f32x4* up = UU + ((size_t)(bh * 3 + seg) * 8 + wid) * 1024 + lane;
#pragma unroll
        for (int a = 0; a < 8; ++a) { up[(a * 2 + 0) * 64] = st[a][0]; up[(a * 2 + 1) * 64] = st[a][1]; }
        if (tid < 128) DSEG[(size_t)(bh * 3 + seg) * 128 + tid] = dprod;
    }
#undef GLA_GLOAD
}

DI float gelu_tanh_(float x) { const float u = 0.7978845608028654f * (x + 0.044715f * x * x * x); const float t = 1.f - 2.f * __builtin_amdgcn_rcpf(__expf(2.f * u) + 1.f); return 0.5f * x * (1.f + t); }
DI void s5_unit(int wv, const Params& P, LAS unsigned char* lds, int item) {
    const int tid_ = tid_from_wave(wv);
    const int tid = tid_, lane = tid & 63, i16 = lane & 15, quad = lane >> 4;
    const int wid = __builtin_amdgcn_readfirstlane(tid >> 6);
    const int pair = item * 8 + wid, b = pair >> 6, g = pair & 63;
    LAS unsigned char* wl = lds + wid * 16384;
    LAS float* bus = (LAS float*)wl;
    LAS unsigned char* xs = wl + 8192;
    bf16_t* PR = (bf16_t*)(P.ws + WS_PROJ);
    const float* a_re = P.in[18]; const float* a_im = P.in[19]; const float* b_re = P.in[21]; const float* b_im = P.in[22];
    const float* c_re = P.in[23]; const float* c_im = P.in[24];
    const float dt = expf(P.in[20][g]);
    float ar, ai;
    { const float lr = a_re[g * 64 + lane], li = a_im[g * 64 + lane]; const float mag = expf(lr * dt); float sn, cs; sincosf(li * dt, &sn, &cs); ar = mag * cs; ai = mag * sn; }
    bf16x8 bfr[8];
#pragma unroll
    for (int k = 0; k < 4; ++k) {
        const int n = 16 * k + i16;
        const float lr = a_re[g * 64 + n], li = a_im[g * 64 + n]; const float mag = expf(lr * dt); float sn, cs; sincosf(li * dt, &sn, &cs);
        const float zr = mag * cs - 1.f, zi = mag * sn, den = lr * lr + li * li;
        const float fr = (zr * lr + zi * li) / den, fi = (zi * lr - zr * li) / den;
        float vr[8], vi[8];
#pragma unroll
        for (int j = 0; j < 8; ++j) { vr[j] = 0.f; vi[j] = 0.f; }
        if (quad < 2) {
            const f32x4 r0 = *(const f32x4*)(b_re + ((size_t)g * 64 + n) * 16 + 8 * quad), r1 = *(const f32x4*)(b_re + ((size_t)g * 64 + n) * 16 + 8 * quad + 4);
            const f32x4 m0 = *(const f32x4*)(b_im + ((size_t)g * 64 + n) * 16 + 8 * quad), m1 = *(const f32x4*)(b_im + ((size_t)g * 64 + n) * 16 + 8 * quad + 4);
            const float br[8] = {r0.x, r0.y, r0.z, r0.w, r1.x, r1.y, r1.z, r1.w}, bi[8] = {m0.x, m0.y, m0.z, m0.w, m1.x, m1.y, m1.z, m1.w};
#pragma unroll
            for (int j = 0; j < 8; ++j) { vr[j] = fr * br[j] - fi * bi[j]; vi[j] = fr * bi[j] + fi * br[j]; }
        }
        u32x4 w; w.x = pk2(vr[0], vr[1]); w.y = pk2(vr[2], vr[3]); w.z = pk2(vr[4], vr[5]); w.w = pk2(vr[6], vr[7]); bfr[k] = __builtin_bit_cast(bf16x8, w);
        w.x = pk2(vi[0], vi[1]); w.y = pk2(vi[2], vi[3]); w.z = pk2(vi[4], vi[5]); w.w = pk2(vi[6], vi[7]); bfr[4 + k] = __builtin_bit_cast(bf16x8, w);
    }
    bf16x8 cfr[4];
#pragma unroll
    for (int s = 0; s < 4; ++s) {
        const float* cp = (s < 2 ? c_re : c_im) + ((size_t)g * 16 + i16) * 64 + 32 * (s & 1) + 8 * quad;
        const f32x4 c0 = *(const f32x4*)cp, c1 = *(const f32x4*)(cp + 4);
        const float sg = s < 2 ? 1.f : -1.f;
        u32x4 w; w.x = pk2(sg * c0.x, sg * c0.y); w.y = pk2(sg * c0.z, sg * c0.w); w.z = pk2(sg * c1.x, sg * c1.y); w.w = pk2(sg * c1.z, sg * c1.w);
        cfr[s] = __builtin_bit_cast(bf16x8, w);
    }
    const float dsk = P.in[25][g * 16 + i16];
    float xr = 0.f, xi = 0.f;
    const bf16_t* ub = PR + (size_t)b * SEQ * PROJ_LD + g * 16;
    bf16_t* zb = (bf16_t*)(P.ws + WS_Q) + (size_t)b * SEQ * Q_LD + g * 16;
    u32x4 ua_n = (u32x4){0u, 0u, 0u, 0u}; bf16_t uv_n[4];
    if (quad < 2) ua_n = *(const u32x4*)(ub + (size_t)i16 * PROJ_LD + 8 * quad);
#pragma unroll
    for (int r = 0; r < 4; ++r) uv_n[r] = ub[(size_t)(4 * quad + r) * PROJ_LD + i16];
    for (int t0 = 0; t0 < SEQ; t0 += 16) {
        const u32x4 ua = ua_n;
        float uv[4];
#pragma unroll
        for (int r = 0; r < 4; ++r) uv[r] = bf2f(uv_n[r]);
        if (t0 + 16 < SEQ) {
            if (quad < 2) ua_n = *(const u32x4*)(ub + (size_t)(t0 + 16 + i16) * PROJ_LD + 8 * quad);
#pragma unroll
            for (int r = 0; r < 4; ++r) uv_n[r] = ub[(size_t)(t0 + 16 + 4 * quad + r) * PROJ_LD + i16];
        }
        const bf16x8 af = __builtin_bit_cast(bf16x8, ua);
#pragma unroll
        for (int nt = 0; nt < 8; ++nt) {
            const f32x4 c = MFMA16(af, bfr[nt], ((f32x4){0.f, 0.f, 0.f, 0.f}));
#pragma unroll
            for (int r = 0; r < 4; ++r) bus[(4 * quad + r) * 128 + 16 * nt + i16] = c[r];
        }
        LDS_WAIT();
        float br_[16], bi_[16];
#pragma unroll
        for (int t = 0; t < 16; ++t) { br_[t] = bus[t * 128 + lane]; bi_[t] = bus[t * 128 + 64 + lane]; }
        LDS_WAIT();
        __builtin_amdgcn_sched_barrier(0);
#pragma unroll
        for (int t = 0; t < 16; ++t) {
            const float nr = ar * xr - ai * xi + br_[t], ni = ar * xi + ai * xr + bi_[t];
            xr = nr; xi = ni; br_[t] = nr; bi_[t] = ni;
        }
        __builtin_amdgcn_sched_barrier(0);
#pragma unroll
        for (int t = 0; t < 16; ++t) {
            *(LAS bf16_t*)(xs + t * 272 + lane * 2) = f2bf(br_[t]);
            *(LAS bf16_t*)(xs + t * 272 + (64 + lane) * 2) = f2bf(bi_[t]);
        }
        LDS_WAIT();
        f32x4 y = (f32x4){0.f, 0.f, 0.f, 0.f};
#pragma unroll
        for (int s = 0; s < 4; ++s) { const bf16x8 a = *(const LAS bf16x8*)(xs + i16 * 272 + (32 * s + 8 * quad) * 2); y = MFMA16(a, cfr[s], y); }
#pragma unroll
        for (int r = 0; r < 4; ++r) { const float yv = y[r] + dsk * uv[r]; zb[(size_t)(t0 + 4 * quad + r) * Q_LD + i16] = f2bf(gelu_tanh_(yv)); }
        LDS_WAIT();
    }
}

#define XB_TMO      128
#define XB_XCNT(j)  (256  + 64 * (j))
#define XB_XSUB(j)  (1280 + 64 * (j))
#define XB_XGEN(j)  (2304 + 64 * (j))
#define XB_TOP      3328
#define XB_TOPGEN   3392
#define XCD_BAR_WORDS 3456
#define XB_SPIN_CAP (1u << 18)
DI unsigned xb_ld(unsigned* p)              { return __hip_atomic_load(p, __ATOMIC_RELAXED, __HIP_MEMORY_SCOPE_AGENT); }
DI unsigned xb_add(unsigned* p, unsigned v) { return __hip_atomic_fetch_add(p, v, __ATOMIC_RELAXED, __HIP_MEMORY_SCOPE_AGENT); }
DI unsigned xb_xcc_id() { return (unsigned)__builtin_amdgcn_s_getreg((3 << 11) | 20) & 0xFu; }
#define XB_SPIN(cond, bar) do { unsigned _sp = 0; while (cond) { __builtin_amdgcn_s_sleep(1); \
    if ((++_sp & 255u) == 0u) { if (xb_ld(&(bar)[XB_TMO])) break; if (_sp > XB_SPIN_CAP) { atomicAdd(&(bar)[XB_TMO], 1u); break; } } } } while (0)
struct XcdBarrier { unsigned* bar; unsigned x; volatile LAS unsigned* st; };
DI XcdBarrier xcd_barrier_post(unsigned* bar, volatile LAS unsigned* st) {
    XcdBarrier b; b.bar = bar; b.x = xb_xcc_id(); b.st = st;
    if (threadIdx.x == 0) (void)xb_add(&bar[XB_XCNT(b.x)], 1u);
    return b;
}
DI void xcd_barrier_complete(unsigned* bar, unsigned x, unsigned& nloc, unsigned& nx) {
    const unsigned G = gridDim.x * gridDim.y * gridDim.z;
    unsigned sum, cnt, mine, sp = 0u;
    for (;;) {
        sum = 0u; cnt = 0u; mine = 0u;
#pragma unroll
        for (unsigned j = 0; j < 16; ++j) { const unsigned c = xb_ld(&bar[XB_XCNT(j)]); sum += c; cnt += (c > 0u) ? 1u : 0u; mine = (j == x) ? c : mine; }
        if (sum == G) break;
        __builtin_amdgcn_s_sleep(1);
        if ((++sp & 255u) == 0u) { if (xb_ld(&bar[XB_TMO])) break; if (sp > XB_SPIN_CAP) { atomicAdd(&bar[XB_TMO], 1u); break; } }
    }
    nloc = mine > 0u ? mine : 1u; nx = cnt > 0u ? cnt : 1u;
}
DI void xcd_barrier(const XcdBarrier& b) {
    asm volatile("s_waitcnt vmcnt(0)" ::: "memory");
    __syncthreads();
    if (threadIdx.x == 0) {
        unsigned* bar = b.bar;
        __builtin_amdgcn_s_waitcnt(0);
        unsigned nloc = b.st[0], nx = b.st[1];
        if (nloc == 0u) { xcd_barrier_complete(bar, b.x, nloc, nx); b.st[0] = nloc; b.st[1] = nx; }
        const unsigned old = xb_add(&bar[XB_XSUB(b.x)], 1u);
        const unsigned gen = old / nloc;
        if (old + 1u == (gen + 1u) * nloc) {
            __builtin_amdgcn_fence(__ATOMIC_RELEASE, "agent");
            asm volatile("s_waitcnt vmcnt(0)" ::: "memory");
            const unsigned og = xb_add(&bar[XB_TOP], 1u);
            const unsigned tg = og / nx;
            if (og + 1u == (tg + 1u) * nx) xb_add(&bar[XB_TOPGEN], 1u);
            else XB_SPIN(xb_ld(&bar[XB_TOPGEN]) == tg, bar);
            __builtin_amdgcn_fence(__ATOMIC_ACQUIRE, "agent");
            xb_add(&bar[XB_XGEN(b.x)], 1u);
            asm volatile("s_waitcnt vmcnt(0)" ::: "memory");
        } else {
            XB_SPIN(xb_ld(&bar[XB_XGEN(b.x)]) == gen, bar);
            __builtin_amdgcn_fence(__ATOMIC_ACQUIRE, "agent");
            asm volatile("s_waitcnt vmcnt(0)" ::: "memory");
        }
    }
    __syncthreads();
}

#ifndef FUSED
#define FUSED 1
#endif
#ifndef DUP_PHASE
#define DUP_PHASE -1
#endif
#ifndef DUP_SUB
#define DUP_SUB 0
#endif
#ifndef EXTRA_SYNCS
#define EXTRA_SYNCS 0
#endif

template <int PH, int REP = 0> DI void run_phase(int wv, const Params& P, LAS unsigned char* lds) {
    const int tid_ = tid_from_wave(wv);
    const int tid = tid_, lane = tid & 63, wave = __builtin_amdgcn_readfirstlane(tid >> 6);
    const int G = gridDim.x, bid = blockIdx.x;
    const int gw = bid * 8 + wave, ngw = G * 8;
    unsigned char* ws = P.ws;
    unsigned* ctl = (unsigned*)(ws + WS_CTL);
    LAS int* qslot = (LAS int*)(lds + MISC_OFF);
    bf16_t* HN = (bf16_t*)(ws + WS_HN); bf16_t* PROJ = (bf16_t*)(ws + WS_PROJ); bf16_t* SMALL = (bf16_t*)(ws + WS_SMALL);
    bf16_t* QB = (bf16_t*)(ws + WS_Q); bf16_t* KVB = (bf16_t*)(ws + WS_KV); bf16_t* ACT = (bf16_t*)(ws + WS_ACT);
    float* H = P.out; float* SS = (float*)(ws + WS_SS);
    if constexpr (PH == 0) {
        if (bid == 0 && tid < 8) ctl[32 * tid] = 0u;
        p0_prologue(P, lds, gw, ngw, wave, lane);
    } else if constexpr (PH == 1) {
        pg8::Gemm g{HN, (const bf16_t*)(ws + WS_WIN0), NTOK, NIN0, DM, DM}; pg8::StaticOrder S; S.init(NTOK, NIN0, G, bid);
        pg8::EpiBf16 E{PROJ, PROJ_LD, 16, SMALL, SMALL_LD, nullptr}; pg8::gemm_phase(lds, g, S, E, wv);
    } else if constexpr (PH == 2) {
        p2_rowpass(P, gw, ngw, lane);
        for (int it = bid; it < 1024; it += G) gla_prep_item(wv, P, lds, it);
    } else if constexpr (PH == 3) {
        { pg8::Gemm g{PROJ, (const bf16_t*)(ws + WS_WUQ), NTOK, 1536, 512, PROJ_LD}; pg8::StaticOrder S; S.init(NTOK, 1536, G, bid);
          pg8::EpiBf16 E{QB, Q_LD, 1 << 30, nullptr, 0, nullptr}; pg8::gemm_phase(lds, g, S, E, wv); }
        { pg8::Gemm g{PROJ + 512, (const bf16_t*)(ws + WS_WUKV), NTOK, 2048, 512, PROJ_LD}; pg8::StaticOrder S; S.init(NTOK, 2048, G, bid);
          pg8::EpiBf16 E{KVB, KV_LD, 1 << 30, nullptr, 0, nullptr}; pg8::gemm_phase(lds, g, S, E, wv); }
        { const int shift = (G >= 224) ? 128 : 0;
          for (int it = bid - shift; it >= 0 && it < 96; it += G) { const int bh = it / 3, sg = it - bh * 3; gla_unit<true>(wv, P, lds, bh >> 2, bh & 3, sg); } }
    } else if constexpr (PH == 4) {
        if (REP == 0 || DUP_SUB != 1) for (;;) {
            if (tid_from_wave(wv) == 0) *qslot = (int)atomicAdd(ctl + 32 + 128 * REP, 1u);
            __syncthreads();
            const int item = *qslot;
            __syncthreads();
            if (item >= 128) break;
            { const int sg = 3 - (item >> 5), bh = item & 31; gla_unit<false>(wv, P, lds, bh >> 2, bh & 3, sg); }
        }
        if (REP == 0 || DUP_SUB != 2) for (;;) {
            if (tid_from_wave(wv) == 0) *qslot = (int)atomicAdd(ctl + 0 + 128 * REP, 1u);
            __syncthreads();
            const int item = *qslot;
            __syncthreads();
            if (item >= 512) break;
            mla_unit(wv, P, lds, item);
        }
    } else if constexpr (PH == 5 || PH == 13) {
        pg8::Gemm g{HN, (const bf16_t*)(ws + (PH == 5 ? WS_WOUT0 : WS_WOUT1)), NTOK, DM, DM, DM}; pg8::StaticOrder S; S.init(NTOK, DM, G, bid);
        pg8::EpiResF32 E{PH == 5 ? P.in[0] : H, H, DM, KVB, SS + (PH == 5 ? 0 : 2) * NTOK}; pg8::gemm_phase(lds, g, S, E, wv);
    } else if constexpr (PH == 7 || PH == 15) {
        pg8::Gemm g{KVB, (const bf16_t*)(ws + (PH == 7 ? WS_WGU0 : WS_WGU1)), NTOK, 2 * FFH, DM, DM}; pg8::StaticOrder S; S.init(NTOK, 2 * FFH, G, bid);
        if (REP == 1 && DUP_SUB == 9) { pg8::EpiNone E{}; pg8::gemm_phase(lds, g, S, E, wv); } else {
        pg8::EpiSwiGLU E{ACT, FFH, SS + (PH == 7 ? 0 : 2) * NTOK}; pg8::gemm_phase(lds, g, S, E, wv); }
    } else if constexpr (PH == 8 || PH == 16) {
        pg8::Gemm g{ACT, (const bf16_t*)(ws + (PH == 8 ? WS_WDN0 : WS_WDN1)), NTOK, DM, FFH, FFH}; pg8::StaticOrder S; S.init(NTOK, DM, G, bid);
        if constexpr (PH == 8) { pg8::EpiResF32 E{H, H, DM, KVB, SS + 1 * NTOK}; pg8::gemm_phase(lds, g, S, E, wv); }
        else { pg8::EpiResNormOut E{H, H, DM, SS + 3 * NTOK, ctl + 2048, P.in[4]}; pg8::gemm_phase(lds, g, S, E, wv); }
    } else if constexpr (PH == 10) {
        pg8::Gemm g{KVB, (const bf16_t*)(ws + WS_WIN1), NTOK, 4096, DM, DM}; pg8::StaticOrder S; S.init(NTOK, 4096, G, bid);
        pg8::EpiBf16 E{PROJ, PROJ_LD, 1 << 30, nullptr, 0, SS + 1 * NTOK}; pg8::gemm_phase(lds, g, S, E, wv);
    } else if constexpr (PH == 11) {
        if (REP == 0 || DUP_SUB != 1) for (;;) {
            if (tid_from_wave(wv) == 0) *qslot = (int)atomicAdd(ctl + 96 + 128 * REP, 1u);
            __syncthreads();
            const int item = *qslot;
            __syncthreads();
            if (item >= 64) break;
            s5_unit(wv, P, lds, item);
        }
        if (REP == 0 || DUP_SUB != 2) for (;;) {
            if (tid_from_wave(wv) == 0) *qslot = (int)atomicAdd(ctl + 64 + 128 * REP, 1u);
            __syncthreads();
            const int item = *qslot;
            __syncthreads();
            if (item >= 512) break;
            diff_unit(wv, P, lds, item);
        }
    } else if constexpr (PH == 12) {
        pg8::Gemm g{QB, (const bf16_t*)(ws + WS_WGLU), NTOK, 1024, 1024, Q_LD}; pg8::StaticOrder S; S.init(NTOK, 1024, G, bid);
        pg8::EpiGLU E{QB, Q_LD, P.in[27], HN, DM}; pg8::gemm_phase(lds, g, S, E, wv);
    } else if constexpr (PH == 17) {
        final_norm_phase(H, P.in[4], SS + 3 * NTOK, gw, ngw, lane);
    }
}

#if FUSED
__global__ void __launch_bounds__(512, 2) hybrid_fwd(Params P) {
    extern __shared__ __attribute__((aligned(16))) unsigned char lds_raw[];
    LAS unsigned char* lds = (LAS unsigned char*)lds_raw;
    cg::grid_group grid = cg::this_grid();
    const int wv = __builtin_amdgcn_readfirstlane((int)threadIdx.x >> 6);
    { LAS unsigned* misc = (LAS unsigned*)(lds + MISC_OFF); if (threadIdx.x < 16) misc[threadIdx.x] = 0u; }
    __syncthreads();
    const XcdBarrier xbar = xcd_barrier_post((unsigned*)(P.ws + WS_CTL) + 4096, (volatile LAS unsigned*)(lds + MISC_OFF + 32));
    if (P.ws == nullptr) grid.sync();
#define SEAM(k) xcd_barrier(xbar)
#define PHASE(k) run_phase<k>(wv, P, lds); SEAM(k); if (DUP_PHASE == k) { run_phase<k, 1>(wv, P, lds); SEAM(k); }
    PHASE(0) PHASE(1) PHASE(2) PHASE(3) PHASE(4) PHASE(5) PHASE(7) PHASE(8)
    PHASE(10) PHASE(11) PHASE(12) PHASE(13) PHASE(15)
    for (int i_ = 0; i_ < EXTRA_SYNCS; ++i_) xcd_barrier(xbar);
    run_phase<16>(wv, P, lds);
#undef PHASE
}
#else
template <int PH> __global__ void __launch_bounds__(512, 2) phase_kernel(Params P) {
    extern __shared__ __attribute__((aligned(16))) unsigned char lds_raw[];
    run_phase<PH>(__builtin_amdgcn_readfirstlane((int)threadIdx.x >> 6), P, (LAS unsigned char*)lds_raw);
}
template <int PH> static void launch_phase(const Params& p, int grid, hipStream_t stream) {
    (void)hipFuncSetAttribute((const void*)phase_kernel<PH>, hipFuncAttributeMaxDynamicSharedMemorySize, LDS_BYTES);
    hipLaunchKernelGGL(phase_kernel<PH>, dim3(grid), dim3(512), LDS_BYTES, stream, p);
}
#endif

extern "C" void kernel_launch(void* const* d_in, const int* in_sizes, int n_in, void* d_out, int out_size, void* d_ws, size_t ws_size, hipStream_t stream) {
    static int grid = 0;
    if (grid == 0) {
        if (n_in != 34 || out_size != NTOK * DM || ws_size < WS_END) { fprintf(stderr, "kernel_launch: unexpected shapes n_in %d out %d ws %zu (need %zu)\n", n_in, out_size, ws_size, (size_t)WS_END); grid = -1; return; }
        int dev = 0, cus = 0;
        (void)hipGetDevice(&dev);
        (void)hipDeviceGetAttribute(&cus, hipDeviceAttributeMultiprocessorCount, dev);
#if FUSED
        int per_cu = 0;
        (void)hipFuncSetAttribute((const void*)hybrid_fwd, hipFuncAttributeMaxDynamicSharedMemorySize, LDS_BYTES);
        (void)hipOccupancyMaxActiveBlocksPerMultiprocessor(&per_cu, (const void*)hybrid_fwd, 512, LDS_BYTES);
        if (per_cu < 1) fprintf(stderr, "kernel_launch: occupancy query says %d blocks per CU\n", per_cu);
#endif
        (void)hipGetLastError();
        grid = cus;
    }
    if (grid < 0) return;
    Params p{};
    for (int i = 0; i < 34; ++i) p.in[i] = (const float*)d_in[i];
    p.out = (float*)d_out; p.ws = (unsigned char*)d_ws;
#if FUSED
    if (hipMemsetAsync((char*)d_ws + WS_CTL, 0, 32768, stream) != hipSuccess) { fprintf(stderr, "kernel_launch: memset of control words failed\n"); return; }
    void* args[] = {&p};
    hipError_t e = hipLaunchCooperativeKernel((const void*)hybrid_fwd, dim3(grid), dim3(512), args, LDS_BYTES, stream);
    if (e != hipSuccess) fprintf(stderr, "cooperative launch failed: %s (grid %d)\n", hipGetErrorString(e), grid);
#else
    launch_phase<0>(p, grid, stream); launch_phase<1>(p, grid, stream); launch_phase<2>(p, grid, stream); launch_phase<3>(p, grid, stream);
    launch_phase<4>(p, grid, stream); launch_phase<5>(p, grid, stream); launch_phase<6>(p, grid, stream); launch_phase<7>(p, grid, stream);
    launch_phase<8>(p, grid, stream); launch_phase<9>(p, grid, stream); launch_phase<10>(p, grid, stream); launch_phase<11>(p, grid, stream);
    launch_phase<12>(p, grid, stream); launch_phase<13>(p, grid, stream); launch_phase<14>(p, grid, stream); launch_phase<15>(p, grid, stream);
    launch_phase<16>(p, grid, stream); launch_phase<17>(p, grid, stream);
#endif
}
```

```cpp
#include <hip/hip_runtime.h>
#include <hip/hip_cooperative_groups.h>
#include <cstdio>
#include <cstdint>
#include <cmath>
namespace cg = cooperative_groups;

#define DI __device__ __forceinline__
#define LAS __attribute__((address_space(3)))
typedef unsigned short bf16_t;
typedef short bf16x8 __attribute__((ext_vector_type(8)));
typedef short s16x4 __attribute__((ext_vector_type(4)));
typedef float f32x4 __attribute__((ext_vector_type(4)));
typedef float f32x2 __attribute__((ext_vector_type(2)));
typedef float f32x16 __attribute__((ext_vector_type(16)));
typedef unsigned u32x4 __attribute__((ext_vector_type(4)));
typedef unsigned u32x2 __attribute__((ext_vector_type(2)));
typedef int i32x4 __attribute__((ext_vector_type(4)));
typedef __bf16 bf16x2_t __attribute__((ext_vector_type(2)));

#define MFMA32(a, b, c) __builtin_amdgcn_mfma_f32_32x32x16_bf16((a), (b), (c), 0, 0, 0)
#define MFMA16(a, b, c) __builtin_amdgcn_mfma_f32_16x16x32_bf16((a), (b), (c), 0, 0, 0)
#define LDS_WAIT() asm volatile("s_waitcnt lgkmcnt(0)" ::: "memory")

DI unsigned pk2(float lo, float hi) { f32x2 v = {lo, hi}; bf16x2_t b = __builtin_convertvector(v, bf16x2_t); return __builtin_bit_cast(unsigned, b); }
DI float bflo(unsigned u) { return __uint_as_float(u << 16); }
DI float bfhi(unsigned u) { return __uint_as_float(u & 0xffff0000u); }
DI float bf2f(bf16_t u) { return __uint_as_float(((unsigned)u) << 16); }
DI bf16_t f2bf(float f) { return (bf16_t)(pk2(f, 0.f) & 0xffffu); }
DI float wave_sum(float v) {
#pragma unroll
    for (int o = 1; o < 64; o <<= 1) v += __shfl_xor(v, o);
    return v;
}
DI int tid_from_wave(int wv) { int l; asm volatile("v_mbcnt_lo_u32_b32 %0, -1, 0\n\tv_mbcnt_hi_u32_b32 %0, -1, %0" : "=v"(l)); int t = wv * 64 + l; asm volatile("" : "+v"(t)); return t; }
DI float dpp_add16(float x) {
    x += __builtin_bit_cast(float, __builtin_amdgcn_update_dpp(0, __builtin_bit_cast(int, x), 0xB1, 0xF, 0xF, true));
    x += __builtin_bit_cast(float, __builtin_amdgcn_update_dpp(0, __builtin_bit_cast(int, x), 0x4E, 0xF, 0xF, true));
    x += __builtin_bit_cast(float, __builtin_amdgcn_update_dpp(0, __builtin_bit_cast(int, x), 0x141, 0xF, 0xF, true));
    x += __builtin_bit_cast(float, __builtin_amdgcn_update_dpp(0, __builtin_bit_cast(int, x), 0x140, 0xF, 0xF, true));
    return x;
}
DI int crow(int r, int hi) { return (r & 3) + 8 * (r >> 2) + 4 * hi; }
DI s16x4 tr_read(const LAS unsigned char* p) { return __builtin_bit_cast(s16x4, __builtin_amdgcn_ds_read_tr16_b64_v4i16((LAS s16x4*)p)); }
DI bf16x8 cat8(s16x4 lo, s16x4 hi) { return (bf16x8){lo[0], lo[1], lo[2], lo[3], hi[0], hi[1], hi[2], hi[3]}; }
DI float sigmoidf_(float x) { return __builtin_amdgcn_rcpf(1.f + __expf(-x)); }
DI float siluf_(float x) { return x * __builtin_amdgcn_rcpf(1.f + __expf(-x)); }

constexpr int NTOK = 16384, SEQ = 2048, NBATCH = 8, DM = 2048, FFH = 5632;
constexpr int PROJ_LD = 4096, SMALL_LD = 128, Q_LD = 1536, KV_LD = 2048;
constexpr int NIN0 = 4352;
constexpr float RMS_EPS = 1e-6f;
constexpr float LOG2E = 1.4426950408889634f;
constexpr float LAMBDA_INIT = 0.35550906759f;

constexpr size_t WS_CTL = 0;
constexpr size_t WS_WIN0 = 1048576;
constexpr size_t WS_SS = 65536;
constexpr size_t WS_WUQ = WS_WIN0 + (size_t)NIN0 * 2048 * 2;
constexpr size_t WS_WUKV = WS_WUQ + (size_t)1536 * 512 * 2;
constexpr size_t WS_WOUT0 = WS_WUKV + (size_t)2048 * 512 * 2;
constexpr size_t WS_WGU0 = WS_WOUT0 + (size_t)2048 * 2048 * 2;
constexpr size_t WS_WDN0 = WS_WGU0 + (size_t)11264 * 2048 * 2;
constexpr size_t WS_WIN1 = WS_WDN0 + (size_t)2048 * 5632 * 2;
constexpr size_t WS_WGLU = WS_WIN1 + (size_t)4096 * 2048 * 2;
constexpr size_t WS_WOUT1 = WS_WGLU + (size_t)1024 * 1024 * 2;
constexpr size_t WS_WGU1 = WS_WOUT1 + (size_t)2048 * 2048 * 2;
constexpr size_t WS_WDN1 = WS_WGU1 + (size_t)11264 * 2048 * 2;
constexpr size_t WS_HN = WS_WDN1 + (size_t)2048 * 5632 * 2;
constexpr size_t WS_PROJ = WS_HN + (size_t)NTOK * 2048 * 2;
constexpr size_t WS_SMALL = WS_PROJ + (size_t)NTOK * 4096 * 2;
constexpr size_t WS_Q = WS_SMALL + (size_t)NTOK * 128 * 2;
constexpr size_t WS_KV = WS_Q + (size_t)NTOK * 1536 * 2;
constexpr size_t WS_END = WS_KV + (size_t)NTOK * 2048 * 2;
constexpr size_t WS_ACT = WS_PROJ;
static_assert(WS_ACT + (size_t)NTOK * FFH * 2 <= WS_END, "ACT overlay");
static_assert(WS_END <= (size_t)512 * 1024 * 1024, "workspace");

constexpr int LDS_RING = 131072, MISC_OFF = LDS_RING, LDS_BYTES = LDS_RING + 1024;

namespace pg8 {
constexpr int BM = 256, BK = 64, HALF = 128, HTB = HALF * BK * 2, NXCD = 8, WGM = 4;
DI int lds_byte(int r, int c) { const int st = (r >> 4) * 2 + (c >> 5), rr = r & 15, cc = c & 31, ob = rr * 64 + cc * 2; return st * 1024 + (ob ^ (((ob >> 9) & 1) << 5)); }
DI void stage_rc(int b, int& R, int& C) { const int st = b / 1024, sb = b % 1024, swz = sb ^ (((sb >> 9) & 1) << 5); R = (st >> 1) * 16 + swz / 64; C = (st & 1) * 32 + (swz % 64) / 2; }
DI int perm32(int rho) { const int n = rho >> 4, i = rho & 15; return 8 * (i >> 2) + 4 * n + (i & 3); }

struct Unit { int pm, pn; };
struct Gemm { const bf16_t* A; const bf16_t* Bt; int M, N, K, lda; };

struct StaticOrder {
    int nM, nN, nwg, G, c;
    DI void init(int M, int N, int G_, int c_) { nM = M / BM; nN = N / BM; nwg = nM * nN; G = G_; c = c_; }
    DI bool next(int i, Unit& u) const {
        const long L = (long)i * G + c; if (L >= nwg) return false;
        int wgid = (int)L; { const int q = nwg / NXCD, r = nwg % NXCD, xcd = wgid % NXCD, off = wgid / NXCD; wgid = (xcd < r ? xcd * (q + 1) : r * (q + 1) + (xcd - r) * q) + off; }
        const int nig = WGM * nN, gid = wgid / nig, fm = gid * WGM, gsz = (nM - fm) < WGM ? (nM - fm) : WGM;
        u.pm = fm + ((wgid % nig) % gsz); u.pn = (wgid % nig) / gsz; return true;
    }
};


struct EpiBf16 {
    static constexpr bool PERM = true;
    bf16_t* O; int ldc; int split_pn; bf16_t* O2; int ld2; const float* ss;
    DI void operator()(const f32x4 (&acc)[2][2][4][2], const Unit& u, int wr, int wc, int fr, int fq) const {
        const int row0 = u.pm * BM + wr * 64 + fr;
        const bool sp = u.pn >= split_pn;
        bf16_t* base = sp ? O2 : O; const int ld = sp ? ld2 : ldc;
        const int col0 = (sp ? 0 : u.pn * BM) + wc * 32 + 8 * fq;
        float rsv[8];
#pragma unroll
        for (int q = 0; q < 8; ++q) rsv[q] = ss ? ss[row0 + (q >> 2) * HALF + (q & 3) * 16] : 0.f;
#pragma unroll
        for (int q = 0; q < 8; ++q) rsv[q] = ss ? 1.f / sqrtf(rsv[q] * (1.f / DM) + RMS_EPS) : 1.f;
#pragma unroll
        for (int ai = 0; ai < 2; ++ai)
#pragma unroll
            for (int m = 0; m < 4; ++m) { const int row = row0 + ai * HALF + m * 16; bf16_t* rowp = base + (size_t)row * ld + col0;
                const float rs = rsv[ai * 4 + m];
#pragma unroll
                for (int bj = 0; bj < 2; ++bj) { if (sp && bj == 1) continue;
                    const f32x4 v0 = acc[ai][bj][m][0] * rs, v1 = acc[ai][bj][m][1] * rs;
                    u32x4 w; w.x = pk2(v0[0], v0[1]); w.y = pk2(v0[2], v0[3]); w.z = pk2(v1[0], v1[1]); w.w = pk2(v1[2], v1[3]);
                    *(u32x4*)(rowp + bj * HALF) = w; } }
    }
};
struct EpiNone { static constexpr bool PERM = true; DI void operator()(const f32x4 (&acc)[2][2][4][2], const Unit& u, int wr, int wc, int fr, int fq) const { float t = 0.f;
#pragma unroll
    for (int a = 0; a < 2; ++a) for (int b = 0; b < 2; ++b) for (int m = 0; m < 4; ++m) for (int n = 0; n < 2; ++n) t += acc[a][b][m][n][0];
    asm volatile("" :: "v"(t)); } };
struct EpiResF32 {
    static constexpr bool PERM = false;
    const float* base; float* out; int ldc; bf16_t* hb; float* ss;
    DI void operator()(const f32x4 (&acc)[2][2][4][2], const Unit& u, int wr, int wc, int fr, int fq) const {
        const int col0 = u.pn * BM + wc * 32 + 4 * fq;
#pragma unroll
        for (int ai = 0; ai < 2; ++ai) {
            f32x4 pre[4][2][2];
#pragma unroll
            for (int m = 0; m < 4; ++m) { const size_t off = (size_t)(u.pm * BM + ai * HALF + wr * 64 + m * 16 + fr) * ldc + col0;
#pragma unroll
                for (int bj = 0; bj < 2; ++bj)
#pragma unroll
                    for (int n = 0; n < 2; ++n) pre[m][bj][n] = *(const f32x4*)(base + off + bj * HALF + n * 16); }
            asm volatile("" ::: "memory");
#pragma unroll
            for (int m = 0; m < 4; ++m) { const int row = u.pm * BM + ai * HALF + wr * 64 + m * 16 + fr; const size_t off = (size_t)row * ldc + col0;
                float sq = 0.f;
#pragma unroll
                for (int bj = 0; bj < 2; ++bj)
#pragma unroll
                    for (int n = 0; n < 2; ++n) { const f32x4 bs = pre[m][bj][n]; const f32x4 v = bs + acc[ai][bj][m][n];
                        *(f32x4*)(out + off + bj * HALF + n * 16) = v;
                        if (ss) sq += (v.x * v.x + v.y * v.y) + (v.z * v.z + v.w * v.w);
                        if (hb) { u32x2 w; w.x = pk2(v.x, v.y); w.y = pk2(v.z, v.w); *(u32x2*)(hb + off + bj * HALF + n * 16) = w; } }
                if (ss) { sq += __shfl_xor(sq, 16); sq += __shfl_xor(sq, 32); if (fq == 0) atomicAdd(ss + row, sq); } }
        }
    }
};
struct EpiSwiGLU {
    static constexpr bool PERM = true;
    bf16_t* O; int ldc; const float* ss;
    DI void operator()(const f32x4 (&acc)[2][2][4][2], const Unit& u, int wr, int wc, int fr, int fq) const {
        const int row0 = u.pm * BM + wr * 64 + fr, col0 = u.pn * HALF + wc * 32 + 8 * fq;
        float rsv[8];
#pragma unroll
        for (int q = 0; q < 8; ++q) rsv[q] = ss[row0 + (q >> 2) * HALF + (q & 3) * 16];
#pragma unroll
        for (int q = 0; q < 8; ++q) rsv[q] = 1.f / sqrtf(rsv[q] * (1.f / DM) + RMS_EPS);
#pragma unroll
        for (int ai = 0; ai < 2; ++ai)
#pragma unroll
            for (int m = 0; m < 4; ++m) { const int row = row0 + ai * HALF + m * 16; bf16_t* rowp = O + (size_t)row * ldc + col0;
                const float rs = rsv[ai * 4 + m];
                float r[8];
#pragma unroll
                for (int n = 0; n < 2; ++n)
#pragma unroll
                    for (int j = 0; j < 4; ++j) { const float g = acc[ai][0][m][n][j] * rs, up = acc[ai][1][m][n][j] * rs; r[n * 4 + j] = siluf_(g) * up; }
                u32x4 w; w.x = pk2(r[0], r[1]); w.y = pk2(r[2], r[3]); w.z = pk2(r[4], r[5]); w.w = pk2(r[6], r[7]);
                *(u32x4*)rowp = w; }
    }
};
struct EpiGLU {
    static constexpr bool PERM = true;
    const bf16_t* Z; int ldz; const float* bias; bf16_t* O; int ldc;
    DI void operator()(const f32x4 (&acc)[2][2][4][2], const Unit& u, int wr, int wc, int fr, int fq) const {
        const int row0 = u.pm * BM + wr * 64 + fr, col0 = u.pn * BM + wc * 32 + 8 * fq;
#pragma unroll
        for (int bj = 0; bj < 2; ++bj) {
            const f32x4 b0 = *(const f32x4*)(bias + col0 + bj * HALF), b1 = *(const f32x4*)(bias + col0 + bj * HALF + 4);
#pragma unroll
            for (int ai = 0; ai < 2; ++ai)
#pragma unroll
                for (int m = 0; m < 4; ++m) { const size_t r = (size_t)(row0 + ai * HALF + m * 16);
                    const u32x4 zz = *(const u32x4*)(Z + r * ldz + col0 + bj * HALF);
                    const f32x4 v0 = acc[ai][bj][m][0] + b0, v1 = acc[ai][bj][m][1] + b1;
                    u32x4 w;
                    w.x = pk2(bflo(zz.x) * sigmoidf_(v0[0]), bfhi(zz.x) * sigmoidf_(v0[1]));
                    w.y = pk2(bflo(zz.y) * sigmoidf_(v0[2]), bfhi(zz.y) * sigmoidf_(v0[3]));
                    w.z = pk2(bflo(zz.z) * sigmoidf_(v1[0]), bfhi(zz.z) * sigmoidf_(v1[1]));
                    w.w = pk2(bflo(zz.w) * sigmoidf_(v1[2]), bfhi(zz.w) * sigmoidf_(v1[3]));
                    *(u32x4*)(O + r * ldc + col0 + bj * HALF) = w; }
        }
    }
};

#ifndef GEMM_SP2
#define GEMM_SP2 true
#endif
template <class Epi, bool SP2 = GEMM_SP2>
DI void gemm_phase(LAS unsigned char* lds, const Gemm g, const StaticOrder& S, const Epi& E, int wv) {
    const int tid_ = tid_from_wave(wv);
    const int tid = tid_, wid = __builtin_amdgcn_readfirstlane(tid >> 6), lane = tid & 63, wr = wid >> 2, wc = wid & 3, fr = lane & 15, fq = lane >> 4;
    const int K = g.K, nt = K / BK, lda = g.lda;
    unsigned voffA[2], voffB[2];
#pragma unroll
    for (int i = 0; i < 2; ++i) { int R, C; stage_rc(tid * 16 + i * 8192, R, C); const int Rb = Epi::PERM ? ((R & ~31) + perm32(R & 31)) : R;
        voffA[i] = (unsigned)(R * lda + C) * 2u; voffB[i] = (unsigned)(Rb * K + C) * 2u; }
    const size_t kstep = (size_t)(BK * 2);
    const size_t hstepA = (size_t)HALF * lda * 2, hstepB = (size_t)HALF * K * 2;
    const size_t tstepA = 2 * hstepA, tstepB = 2 * hstepB;
    const unsigned ldsw = (unsigned)wid * 1024u;
    const int aoff = lds_byte(wr * 64 + fr, fq * 8), boff = lds_byte(wc * 32 + fr, fq * 8);
#define PG8_SA(b, h) (((b) * 2 + (h)) * HTB)
#define PG8_SB(b, h) ((4 + (b) * 2 + (h)) * HTB)
#define PG8_STAGE(bufoff, gbase, voff) do { _Pragma("unroll") for (int _i = 0; _i < 2; ++_i) \
        __builtin_amdgcn_global_load_lds((const unsigned*)((const char*)(gbase) + (voff)[_i]), (LAS unsigned*)(lds + (bufoff) + ldsw + _i * 8192), 16, 0, 0); } while (0)
#define PG8_LDA(dst, b, h) do { _Pragma("unroll") for (int m = 0; m < 4; ++m) _Pragma("unroll") for (int k = 0; k < 2; ++k) dst[m][k] = *(const LAS bf16x8*)(lds + PG8_SA(b, h) + aoff + m * 2048 + k * 1024); } while (0)
#define PG8_LDB(dst, b, h) do { _Pragma("unroll") for (int n = 0; n < 2; ++n) _Pragma("unroll") for (int k = 0; k < 2; ++k) dst[n][k] = *(const LAS bf16x8*)(lds + PG8_SB(b, h) + boff + n * 2048 + k * 1024); } while (0)
#define PG8_MMA(ai, bj, At, Bt) do { __builtin_amdgcn_s_setprio(1); _Pragma("unroll") for (int m = 0; m < 4; ++m) _Pragma("unroll") for (int n = 0; n < 2; ++n) _Pragma("unroll") for (int k = 0; k < 2; ++k) \
        acc[ai][bj][m][n] = __builtin_amdgcn_mfma_f32_16x16x32_bf16(Bt[n][k], At[m][k], acc[ai][bj][m][n], 0, 0, 0); __builtin_amdgcn_s_setprio(0); } while (0)
#define PG8_WAIT_V(n) asm volatile("s_waitcnt vmcnt(" #n ")" ::: "memory")
#define PG8_WAIT_L(n) asm volatile("s_waitcnt lgkmcnt(" #n ")" ::: "memory")
#define PG8_BAR __builtin_amdgcn_s_barrier()
#define PG8_SCHED __builtin_amdgcn_sched_barrier(0)
    Unit cur, nxt; int ui = 0;
    if (!S.next(0, cur)) return;
    f32x4 acc[2][2][4][2];
#pragma unroll
    for (int a = 0; a < 2; ++a)
#pragma unroll
        for (int b = 0; b < 2; ++b)
#pragma unroll
            for (int m = 0; m < 4; ++m)
#pragma unroll
                for (int n = 0; n < 2; ++n) acc[a][b][m][n] = (f32x4){0.f, 0.f, 0.f, 0.f};
    bf16x8 At[4][2], B0[2][2], B1[2][2];
    const char* cA = (const char*)g.A + (size_t)cur.pm * tstepA; const char* cB = (const char*)g.Bt + (size_t)cur.pn * tstepB;
    if constexpr (SP2) {
    PG8_STAGE(PG8_SB(0, 0), cB, voffB); PG8_STAGE(PG8_SB(0, 1), cB + hstepB, voffB); PG8_STAGE(PG8_SA(0, 0), cA, voffA); PG8_STAGE(PG8_SA(0, 1), cA + hstepA, voffA);
    if (wr == 1) PG8_BAR;
    PG8_WAIT_V(2); PG8_BAR;
    PG8_STAGE(PG8_SB(1, 0), cB + kstep, voffB); PG8_STAGE(PG8_SA(1, 0), cA + kstep, voffA); PG8_STAGE(PG8_SB(1, 1), cB + hstepB + kstep, voffB);
    PG8_WAIT_V(6); PG8_BAR;
    } else {
    PG8_STAGE(PG8_SB(0, 0), cB, voffB); PG8_STAGE(PG8_SA(0, 0), cA, voffA); PG8_STAGE(PG8_SB(0, 1), cB + hstepB, voffB); PG8_STAGE(PG8_SA(0, 1), cA + hstepA, voffA);
    if (wr == 1) PG8_BAR;
    PG8_WAIT_V(4); PG8_BAR;
    PG8_STAGE(PG8_SB(1, 0), cB + kstep, voffB); PG8_STAGE(PG8_SA(1, 0), cA + kstep, voffA); PG8_STAGE(PG8_SB(1, 1), cB + hstepB + kstep, voffB);
    PG8_WAIT_V(6); PG8_BAR;
    }
    for (;;) {
        const bool has_next = S.next(ui + 1, nxt);
        const char* nA = has_next ? (const char*)g.A + (size_t)nxt.pm * tstepA : cA; const char* nB = has_next ? (const char*)g.Bt + (size_t)nxt.pn * tstepB : cB;
        for (int t = 0; t < nt; t += 2) {
            const bool last = (t == nt - 2);
            const char* a1 = cA + (size_t)(t + 1) * kstep;
            const char* a2 = last ? nA : cA + (size_t)(t + 2) * kstep; const char* b2 = last ? nB : cB + (size_t)(t + 2) * kstep;
            const char* a3 = a2 + kstep; const char* b3 = b2 + kstep;
            if constexpr (!SP2) {
            PG8_LDB(B0, 0, 0); PG8_SCHED; PG8_LDA(At, 0, 0); PG8_STAGE(PG8_SA(1, 1), a1 + hstepA, voffA);
            PG8_WAIT_L(8); PG8_BAR; PG8_WAIT_L(0); PG8_MMA(0, 0, At, B0); PG8_BAR; PG8_SCHED;
            PG8_LDB(B1, 0, 1); PG8_STAGE(PG8_SB(0, 0), b2, voffB);
            PG8_BAR; PG8_WAIT_L(0); PG8_MMA(0, 1, At, B1); PG8_BAR;
            PG8_LDA(At, 0, 1); PG8_STAGE(PG8_SA(0, 0), a2, voffA);
            PG8_BAR; PG8_WAIT_L(0); PG8_MMA(1, 0, At, B0); PG8_BAR; PG8_SCHED;
            PG8_STAGE(PG8_SB(0, 1), b2 + hstepB, voffB);
            PG8_WAIT_V(6); PG8_BAR; PG8_MMA(1, 1, At, B1); PG8_BAR;
            PG8_LDB(B0, 1, 0); PG8_SCHED; PG8_LDA(At, 1, 0); PG8_STAGE(PG8_SA(0, 1), a2 + hstepA, voffA);
            PG8_WAIT_L(8); PG8_BAR; PG8_WAIT_L(0); PG8_MMA(0, 0, At, B0); PG8_BAR; PG8_SCHED;
            PG8_LDB(B1, 1, 1); PG8_STAGE(PG8_SB(1, 0), b3, voffB);
            PG8_BAR; PG8_WAIT_L(0); PG8_MMA(0, 1, At, B1); PG8_BAR;
            PG8_LDA(At, 1, 1); PG8_STAGE(PG8_SA(1, 0), a3, voffA);
            PG8_BAR; PG8_WAIT_L(0); PG8_MMA(1, 0, At, B0); PG8_BAR; PG8_SCHED;
            PG8_STAGE(PG8_SB(1, 1), b3 + hstepB, voffB);
            PG8_WAIT_V(6); PG8_BAR; PG8_MMA(1, 1, At, B1); PG8_BAR;
            } else {
            PG8_LDB(B0, 0, 0); PG8_LDB(B1, 0, 1); PG8_SCHED; PG8_LDA(At, 0, 0); PG8_STAGE(PG8_SA(1, 1), a1 + hstepA, voffA);
            PG8_WAIT_V(8); PG8_WAIT_L(0); PG8_BAR; PG8_MMA(0, 0, At, B0); PG8_MMA(0, 1, At, B1); PG8_BAR; PG8_SCHED;
            PG8_LDA(At, 0, 1); PG8_STAGE(PG8_SB(0, 0), b2, voffB); PG8_STAGE(PG8_SB(0, 1), b2 + hstepB, voffB); PG8_STAGE(PG8_SA(0, 0), a2, voffA);
            PG8_WAIT_V(8); PG8_WAIT_L(0); PG8_BAR; PG8_MMA(1, 0, At, B0); PG8_MMA(1, 1, At, B1); PG8_BAR; PG8_SCHED;
            PG8_LDB(B0, 1, 0); PG8_LDB(B1, 1, 1); PG8_SCHED; PG8_LDA(At, 1, 0); PG8_STAGE(PG8_SA(0, 1), a2 + hstepA, voffA);
            PG8_WAIT_V(8); PG8_WAIT_L(0); PG8_BAR; PG8_MMA(0, 0, At, B0); PG8_MMA(0, 1, At, B1); PG8_BAR; PG8_SCHED;
            PG8_LDA(At, 1, 1); PG8_STAGE(PG8_SB(1, 0), b3, voffB); PG8_STAGE(PG8_SB(1, 1), b3 + hstepB, voffB); PG8_STAGE(PG8_SA(1, 0), a3, voffA);
            PG8_WAIT_V(8); PG8_WAIT_L(0); PG8_BAR; PG8_MMA(1, 0, At, B0); PG8_MMA(1, 1, At, B1); PG8_BAR; PG8_SCHED;
            }
        }
        if (wr == 0) PG8_BAR;
        E(acc, cur, wr, wc, fr, fq);
        if (!has_next) break;
#pragma unroll
        for (int a = 0; a < 2; ++a)
#pragma unroll
            for (int b = 0; b < 2; ++b)
#pragma unroll
                for (int m = 0; m < 4; ++m)
#pragma unroll
                    for (int n = 0; n < 2; ++n) acc[a][b][m][n] = (f32x4){0.f, 0.f, 0.f, 0.f};
        cur = nxt; cA = nA; cB = nB; ++ui;
        if (wr == 1) PG8_BAR;
    }
    PG8_WAIT_V(0);
    PG8_BAR;
#undef PG8_SA
#undef PG8_SB
#undef PG8_STAGE
#undef PG8_LDA
#undef PG8_LDB
#undef PG8_MMA
#undef PG8_WAIT_V
#undef PG8_WAIT_L
#undef PG8_BAR
#undef PG8_SCHED
}
}

struct Params {
    const float* in[34];
    float* out;
    unsigned char* ws;
};

DI int rowmap(int mode, int n) {
    if (mode == 0) return n;
    if (mode == 1) {
        if (n < 1024) return n;
        if (n < 1088) return 4096 + (n - 1024);
        if (n < 2112) return 1024 + (n - 1088);
        if (n < 3136) return 2048 + (n - 2112);
        if (n < 3152) return 4096 + 64 + (n - 3136);
        return 3072 + (n - 3152);
    }
    if (mode == 2) return (n >> 7) * 256 + (n & 127);
    return (n >> 7) * 256 + 128 + (n & 127);
}
DI void transpose_item(const float* __restrict__ W, int K, int N, bf16_t* WT, int mode, LAS float* scr, int item, int lane, const float* kscale = nullptr) {
    const int nblk = (N + 31) >> 5, kb = item / nblk, nb = item - kb * nblk, k0 = 64 * kb, n0 = 32 * nb;
    const int r8 = lane >> 3, c4 = (lane & 7) * 4;
    const bool okl = n0 + c4 < N;
    f32x4 v[8];
    const float* src = W + (size_t)(k0 + r8) * N + n0 + c4;
#pragma unroll
    for (int i = 0; i < 8; ++i) v[i] = okl ? *(const f32x4*)(src + (size_t)(8 * i) * N) : (f32x4){0.f, 0.f, 0.f, 0.f};
    if (kscale) {
#pragma unroll
        for (int i = 0; i < 8; ++i) v[i] = v[i] * kscale[k0 + r8 + 8 * i];
    }
#pragma unroll
    for (int i = 0; i < 8; ++i) { LAS float* d = scr + (r8 + 8 * i) * 33 + c4; d[0] = v[i].x; d[1] = v[i].y; d[2] = v[i].z; d[3] = v[i].w; }
    LDS_WAIT();
    const int c = lane & 7;
#pragma unroll
    for (int j = 0; j < 4; ++j) { const int n = (lane >> 3) + 8 * j; const LAS float* s = scr + (8 * c) * 33 + n;
        u32x4 o; o.x = pk2(s[0 * 33], s[1 * 33]); o.y = pk2(s[2 * 33], s[3 * 33]); o.z = pk2(s[4 * 33], s[5 * 33]); o.w = pk2(s[6 * 33], s[7 * 33]);
        if (n0 + n < N) *(u32x4*)(WT + (size_t)rowmap(mode, n0 + n) * K + k0 + 8 * c) = o; }
    LDS_WAIT();
}
DI void rms_row_bf16(const float* xrow, const float* g, bf16_t* orow, int lane) {
    const f32x4* xr = (const f32x4*)xrow + lane; const f32x4* gr = (const f32x4*)g + lane;
    f32x4 v[8]; float s = 0.f;
#pragma unroll
    for (int j = 0; j < 8; ++j) { v[j] = xr[64 * j]; s += (v[j].x * v[j].x + v[j].y * v[j].y) + (v[j].z * v[j].z + v[j].w * v[j].w); }
    const float rstd = 1.f / sqrtf(wave_sum(s) * (1.f / DM) + RMS_EPS);
    u32x2* o8 = (u32x2*)orow + lane;
#pragma unroll
    for (int j = 0; j < 8; ++j) { const f32x4 gg = gr[64 * j]; u32x2 w; w.x = pk2(v[j].x * rstd * gg.x, v[j].y * rstd * gg.y); w.y = pk2(v[j].z * rstd * gg.z, v[j].w * rstd * gg.w); o8[64 * j] = w; }
}
DI void rms_rows_phase(const float* src, const float* g, bf16_t* dst, int gw, int ngw, int lane) {
    const f32x4* gr = (const f32x4*)g + lane;
    for (int m = gw; m < NTOK; m += 2 * ngw) {
        const int m2 = (m + ngw < NTOK) ? m + ngw : m;
        const f32x4* xa = (const f32x4*)(src + (size_t)m * DM) + lane; const f32x4* xb = (const f32x4*)(src + (size_t)m2 * DM) + lane;
        f32x4 va[8], vb[8]; float sa = 0.f, sb = 0.f;
#pragma unroll
        for (int j = 0; j < 8; ++j) va[j] = xa[64 * j];
#pragma unroll
        for (int j = 0; j < 8; ++j) vb[j] = xb[64 * j];
#pragma unroll
        for (int j = 0; j < 8; ++j) { sa += (va[j].x * va[j].x + va[j].y * va[j].y) + (va[j].z * va[j].z + va[j].w * va[j].w); sb += (vb[j].x * vb[j].x + vb[j].y * vb[j].y) + (vb[j].z * vb[j].z + vb[j].w * vb[j].w); }
        const float ra = 1.f / sqrtf(wave_sum(sa) * (1.f / DM) + RMS_EPS), rb = 1.f / sqrtf(wave_sum(sb) * (1.f / DM) + RMS_EPS);
        u32x2* oa = (u32x2*)(dst + (size_t)m * DM) + lane; u32x2* ob = (u32x2*)(dst + (size_t)m2 * DM) + lane;
#pragma unroll
        for (int j = 0; j < 8; ++j) { const f32x4 gg = gr[64 * j]; u32x2 w;
            w.x = pk2(va[j].x * ra * gg.x, va[j].y * ra * gg.y); w.y = pk2(va[j].z * ra * gg.z, va[j].w * ra * gg.w); oa[64 * j] = w;
            w.x = pk2(vb[j].x * rb * gg.x, vb[j].y * rb * gg.y); w.y = pk2(vb[j].z * rb * gg.z, vb[j].w * rb * gg.w); ob[64 * j] = w; }
    }
}
DI void final_norm_phase(float* h, const float* g, const float* ss, int gw, int ngw, int lane) {
    const f32x4* gr = (const f32x4*)g + lane;
    for (int m = gw; m < NTOK; m += 2 * ngw) {
        const int m2 = m + ngw; const bool has2 = m2 < NTOK;
        f32x4* xa = (f32x4*)(h + (size_t)m * DM) + lane; f32x4* xb = (f32x4*)(h + (size_t)(has2 ? m2 : m) * DM) + lane;
        f32x4 va[8], vb[8];
#pragma unroll
        for (int j = 0; j < 8; ++j) va[j] = xa[64 * j];
#pragma unroll
        for (int j = 0; j < 8; ++j) vb[j] = xb[64 * j];
        const float ra = 1.f / sqrtf(ss[m] * (1.f / DM) + RMS_EPS), rb = 1.f / sqrtf(ss[has2 ? m2 : m] * (1.f / DM) + RMS_EPS);
#pragma unroll
        for (int j = 0; j < 8; ++j) { const f32x4 gg = gr[64 * j]; xa[64 * j] = va[j] * ra * gg; if (has2) xb[64 * j] = vb[j] * rb * gg; }
    }
}

DI void p0_prologue(const Params& P, LAS unsigned char* lds, int gw, int ngw, int wave, int lane) {
    LAS float* scr = (LAS float*)(lds + wave * 16384);
    unsigned char* ws = P.ws;
    constexpr int I_IN0 = 32 * 131, I_UQ = 8 * 48, I_UKV = 8 * 64, I_OUT = 32 * 64, I_GU = 32 * 176, I_DN = 88 * 64, I_IN1 = 32 * 128, I_GLU = 16 * 32;
    constexpr int NITEMS = I_IN0 + I_UQ + I_UKV + 2 * I_OUT + 4 * I_GU + 2 * I_DN + I_IN1 + I_GLU;
    constexpr size_t FW = (size_t)DM * FFH;
    for (int it = gw; it < NITEMS; it += ngw) {
        int r = it;
        if (r < I_GU) { transpose_item(P.in[5], DM, FFH, (bf16_t*)(ws + WS_WGU0), 2, scr, r, lane, P.in[3]); continue; } r -= I_GU;
        if (r < I_GU) { transpose_item(P.in[6], DM, FFH, (bf16_t*)(ws + WS_WGU0), 3, scr, r, lane, P.in[3]); continue; } r -= I_GU;
        if (r < I_DN) { transpose_item(P.in[7], FFH, DM, (bf16_t*)(ws + WS_WDN0), 0, scr, r, lane); continue; } r -= I_DN;
        if (r < I_GU) { transpose_item(P.in[5] + FW, DM, FFH, (bf16_t*)(ws + WS_WGU1), 2, scr, r, lane, P.in[3] + DM); continue; } r -= I_GU;
        if (r < I_GU) { transpose_item(P.in[6] + FW, DM, FFH, (bf16_t*)(ws + WS_WGU1), 3, scr, r, lane, P.in[3] + DM); continue; } r -= I_GU;
        if (r < I_DN) { transpose_item(P.in[7] + FW, FFH, DM, (bf16_t*)(ws + WS_WDN1), 0, scr, r, lane); continue; } r -= I_DN;
        if (r < I_IN0) { transpose_item(P.in[8], DM, 4176, (bf16_t*)(ws + WS_WIN0), 1, scr, r, lane); continue; } r -= I_IN0;
        if (r < I_UQ) { transpose_item(P.in[10], 512, 1536, (bf16_t*)(ws + WS_WUQ), 0, scr, r, lane); continue; } r -= I_UQ;
        if (r < I_UKV) { transpose_item(P.in[12], 512, 2048, (bf16_t*)(ws + WS_WUKV), 0, scr, r, lane); continue; } r -= I_UKV;
        if (r < I_OUT) { transpose_item(P.in[16], DM, DM, (bf16_t*)(ws + WS_WOUT0), 0, scr, r, lane); continue; } r -= I_OUT;
        if (r < I_IN1) { transpose_item(P.in[17], DM, 4096, (bf16_t*)(ws + WS_WIN1), 0, scr, r, lane, P.in[2] + DM); continue; } r -= I_IN1;
        if (r < I_GLU) { transpose_item(P.in[26], 1024, 1024, (bf16_t*)(ws + WS_WGLU), 0, scr, r, lane); continue; } r -= I_GLU;
        transpose_item(P.in[33], DM, DM, (bf16_t*)(ws + WS_WOUT1), 0, scr, r, lane);
    }
    { u32x4* z = (u32x4*)(ws + WS_WIN0 + (size_t)(4096 + 80) * 2048 * 2); const int n16 = (NIN0 - 4096 - 80) * 2048 * 2 / 16;
      for (int i = gw * 64 + lane; i < n16; i += ngw * 64) z[i] = (u32x4){0u, 0u, 0u, 0u}; }
    { float* ssz = (float*)(ws + WS_SS); for (int i = gw * 64 + lane; i < 4 * NTOK; i += ngw * 64) ssz[i] = 0.f; }
    rms_rows_phase(P.in[0], P.in[2], (bf16_t*)(ws + WS_HN), gw, ngw, lane);
}

DI void p2_rowpass(const Params& P, int gw, int ngw, int lane) {
    bf16_t* proj = (bf16_t*)(P.ws + WS_PROJ); bf16_t* small = (bf16_t*)(P.ws + WS_SMALL);
    const int* pos = (const int*)P.in[1];
    for (int m = gw; m < NTOK; m += ngw) {
#pragma unroll
        for (int part = 0; part < 2; ++part) {
            u32x4* p = (u32x4*)(proj + (size_t)m * PROJ_LD + part * 512) + lane;
            const u32x4 w = *p; float f[8] = {bflo(w.x), bfhi(w.x), bflo(w.y), bfhi(w.y), bflo(w.z), bfhi(w.z), bflo(w.w), bfhi(w.w)};
            float s = 0.f;
#pragma unroll
            for (int j = 0; j < 8; ++j) s += f[j] * f[j];
            const float rstd = 1.f / sqrtf(wave_sum(s) * (1.f / 512.f) + RMS_EPS);
            const float* g = (part == 0 ? P.in[9] : P.in[11]) + lane * 8;
            const f32x4 g0 = *(const f32x4*)g, g1 = *(const f32x4*)(g + 4);
            u32x4 o; o.x = pk2(f[0] * rstd * g0.x, f[1] * rstd * g0.y); o.y = pk2(f[2] * rstd * g0.z, f[3] * rstd * g0.w);
            o.z = pk2(f[4] * rstd * g1.x, f[5] * rstd * g1.y); o.w = pk2(f[6] * rstd * g1.z, f[7] * rstd * g1.w);
            *p = o;
        }
        {
            bf16_t* kr = small + (size_t)m * SMALL_LD;
            const int j = lane & 31;
            const float t1 = bf2f(kr[j]), t2 = bf2f(kr[j + 32]);
            const float invf = exp2f(-(float)j * (13.287712379549449f / 32.f));
            const float ang = (float)pos[m] * invf;
            float sn, cs; sincosf(ang, &sn, &cs);
            if (lane < 32) { kr[j] = f2bf(t1 * cs - t2 * sn); kr[j + 32] = f2bf(t2 * cs + t1 * sn);
                float* tab = (float*)((unsigned char*)P.out + ((size_t)32 << 20)) + (size_t)m * 64; tab[j] = cs; tab[32 + j] = sn; }
        }
    }
}

#define DPPF(x, ctrl) __builtin_bit_cast(float, __builtin_amdgcn_update_dpp(0, __builtin_bit_cast(int, (x)), (ctrl), 0xF, 0xF, true))
template <int DQK, bool ALIBI, bool MLA>
DI void flash_unit(int wv, LAS unsigned char* lds, const bf16x8 (&qf)[DQK / 16],
                   const bf16_t* Kp, int kpitch, const bf16_t* K2p, int k2pitch, const bf16_t* Vp, int vpitch,
                   const int* posb, int q0, int posq, float slope_l2, f32x16 (&o)[4]) {
    constexpr int KP = (DQK + 8) * 2, VPB = 320, KOFF = 0, VOFF = 64 * KP, POSOFF = VOFF + 64 * VPB, STATOFF = POSOFF + 256, BUFSZ = STATOFF + 64;
    constexpr bool REV = ALIBI;
    constexpr int CPR = DQK / 8;
    constexpr int NKC = 64 * CPR / 512;
    const int tid_ = tid_from_wave(wv);
    const int tid = tid_, lane = tid & 63, r32 = lane & 31, hi = lane >> 5;
    const int wid = __builtin_amdgcn_readfirstlane(tid >> 6);
    const int NT = (q0 + 256) / 64;
    const int qw0 = q0 + 32 * wid, qrow = qw0 + r32;
    u32x4 kreg[NKC], vreg[2]; int preg = 0;
    unsigned koff[NKC]; const unsigned voff0 = (unsigned)((tid >> 4) * vpitch + 8 * (tid & 15));
#pragma unroll
    for (int i_ = 0; i_ < NKC; ++i_) { const int c_ = tid + 512 * i_, key_ = c_ / CPR, ch_ = c_ - key_ * CPR;
        koff[i_] = (MLA && ch_ >= 16) ? (unsigned)(key_ * k2pitch + 8 * (ch_ - 16)) : (unsigned)(key_ * kpitch + 8 * ch_); }
#define FL_GLOAD(t) do { const bf16_t* kt_ = Kp + (size_t)(64 * (t)) * kpitch; const bf16_t* k2t_ = MLA ? K2p + (size_t)(64 * (t)) * k2pitch : Kp; const bf16_t* vt_ = Vp + (size_t)(64 * (t)) * vpitch; \
        _Pragma("unroll") for (int i_ = 0; i_ < NKC; ++i_) { const int c_ = tid + 512 * i_, key_ = c_ / CPR, ch_ = c_ - key_ * CPR; \
            if (MLA) kreg[i_] = (ch_ < 16) ? *(const u32x4*)(kt_ + koff[i_]) : *(const u32x4*)(k2t_ + koff[i_]); \
            else kreg[i_] = *(const u32x4*)(kt_ + koff[i_]); } \
        vreg[0] = *(const u32x4*)(vt_ + voff0); vreg[1] = *(const u32x4*)(vt_ + (size_t)32 * vpitch + voff0); \
        if (ALIBI) { if (tid < 64) preg = (posb + 64 * (t))[tid]; } } while (0)
#define FL_LSTORE(buf) do { LAS unsigned char* b_ = lds + (buf) * BUFSZ; \
        _Pragma("unroll") for (int i_ = 0; i_ < NKC; ++i_) { const int c_ = tid + 512 * i_, key_ = c_ / CPR, ch_ = c_ - key_ * CPR; *(LAS u32x4*)(b_ + KOFF + key_ * KP + ch_ * 16) = kreg[i_]; } \
        _Pragma("unroll") for (int i_ = 0; i_ < 2; ++i_) { const int c_ = tid + 512 * i_, key_ = c_ >> 4, ch_ = c_ & 15; *(LAS u32x4*)(b_ + VOFF + key_ * VPB + ch_ * 16) = vreg[i_]; } \
        if (ALIBI) { if (tid < 64) *(LAS int*)(b_ + POSOFF + 4 * tid) = preg; \
              \
            { const u32x4 w_ = kreg[0]; float a0_ = bflo(w_.x), a1_ = bfhi(w_.x), a2_ = bflo(w_.y), a3_ = bfhi(w_.y), a4_ = bflo(w_.z), a5_ = bfhi(w_.z), a6_ = bflo(w_.w), a7_ = bfhi(w_.w); \
              float q_ = (a0_ * a0_ + a1_ * a1_) + (a2_ * a2_ + a3_ * a3_) + (a4_ * a4_ + a5_ * a5_) + (a6_ * a6_ + a7_ * a7_); \
              q_ += DPPF(q_, 0xB1); q_ += DPPF(q_, 0x4E); q_ += DPPF(q_, 0x141); q_ = fmaxf(q_, DPPF(q_, 0x140)); \
              q_ = fmaxf(q_, __shfl_xor(q_, 16)); q_ = fmaxf(q_, __shfl_xor(q_, 32)); \
              if (lane == 0) *(LAS float*)(b_ + STATOFF + 4 * wid) = q_; } \
            if (tid < 64) { int mn_ = preg, mx_ = preg; \
              _Pragma("unroll") for (int o_ = 1; o_ < 64; o_ <<= 1) { const int a_ = __shfl_xor(mn_, o_), c_ = __shfl_xor(mx_, o_); mn_ = a_ < mn_ ? a_ : mn_; mx_ = c_ > mx_ ? c_ : mx_; } \
              if (tid == 0) { *(LAS int*)(b_ + STATOFF + 32) = mn_; *(LAS int*)(b_ + STATOFF + 36) = mx_; } } } } while (0)
    float mrun = -INFINITY, lrun = 0.f;
#pragma unroll
    for (int d = 0; d < 4; ++d)
#pragma unroll
        for (int r = 0; r < 16; ++r) o[d][r] = 0.f;
    float qn = 0.f;
    if (ALIBI) {
#pragma unroll
        for (int s = 0; s < DQK / 16; ++s) { const u32x4 w = __builtin_bit_cast(u32x4, qf[s]);
            qn += (bflo(w.x) * bflo(w.x) + bfhi(w.x) * bfhi(w.x)) + (bflo(w.y) * bflo(w.y) + bfhi(w.y) * bfhi(w.y)) + (bflo(w.z) * bflo(w.z) + bfhi(w.z) * bfhi(w.z)) + (bflo(w.w) * bflo(w.w) + bfhi(w.w) * bfhi(w.w)); }
        qn += __shfl_xor(qn, 32);
        qn = sqrtf(qn) * 1.02f;
    }
    FL_GLOAD(REV ? NT - 1 : 0); FL_LSTORE(0);
    __syncthreads();
    const int i16 = lane & 15, g16 = (lane >> 4) & 1;
    for (int it = 0; it < NT; ++it) {
        const int t = REV ? NT - 1 - it : it;
        const int buf = it & 1;
        if (it + 1 < NT) FL_GLOAD(REV ? t - 1 : t + 1);
        bool skip = false;
        if (ALIBI) {
            const LAS unsigned char* sb = lds + buf * BUFSZ + STATOFF;
            const f32x4 s0 = *(const LAS f32x4*)sb, s1 = *(const LAS f32x4*)(sb + 16);
            const float k2 = fmaxf(fmaxf(fmaxf(s0.x, s0.y), fmaxf(s0.z, s0.w)), fmaxf(fmaxf(s1.x, s1.y), fmaxf(s1.z, s1.w)));
            const int pmn = *(const LAS int*)(sb + 32), pmx = *(const LAS int*)(sb + 36);
            int dm = posq - pmx; const int dm2 = pmn - posq; dm = dm > dm2 ? dm : dm2; dm = dm > 0 ? dm : 0;
            const bool c = (qn * sqrtf(k2) * 1.02f - slope_l2 * (float)dm - mrun) < -40.f;
            skip = __all(c) != 0;
        }
        if (64 * t <= qw0 + 31 && !skip) {
            const LAS unsigned char* kb = lds + buf * BUFSZ + KOFF + r32 * KP + hi * 16;
            f32x16 p0, p1;
#pragma unroll
            for (int r = 0; r < 16; ++r) { p0[r] = 0.f; p1[r] = 0.f; }
#pragma unroll
            for (int s = 0; s < DQK / 16; ++s) {
                const bf16x8 a0 = *(const LAS bf16x8*)(kb + s * 32), a1 = *(const LAS bf16x8*)(kb + 32 * KP + s * 32);
                p0 = MFMA32(a0, qf[s], p0); p1 = MFMA32(a1, qf[s], p1);
                if ((s & 3) == 3) __builtin_amdgcn_sched_barrier(0);
            }
            if (ALIBI) {
                const LAS unsigned char* pb = lds + buf * BUFSZ + POSOFF;
#pragma unroll
                for (int g = 0; g < 4; ++g) {
                    const i32x4 k0 = *(const LAS i32x4*)(pb + (8 * g + 4 * hi) * 4), k1 = *(const LAS i32x4*)(pb + (32 + 8 * g + 4 * hi) * 4);
#pragma unroll
                    for (int j = 0; j < 4; ++j) {
                        int d0 = posq - k0[j]; d0 = d0 < 0 ? -d0 : d0; int d1 = posq - k1[j]; d1 = d1 < 0 ? -d1 : d1;
                        p0[4 * g + j] -= slope_l2 * (float)d0; p1[4 * g + j] -= slope_l2 * (float)d1;
                    }
                }
            }
            if (64 * t + 63 > qw0) {
#pragma unroll
                for (int r = 0; r < 16; ++r) { const int key = 64 * t + crow(r, hi); if (key > qrow) p0[r] = -INFINITY; if (key + 32 > qrow) p1[r] = -INFINITY; }
            }
            float rm = fmaxf(p0[0], p1[0]);
#pragma unroll
            for (int r = 1; r < 16; ++r) rm = fmaxf(rm, fmaxf(p0[r], p1[r]));
            { auto rr_ = __builtin_amdgcn_permlane32_swap(__float_as_uint(rm), __float_as_uint(rm), false, false); rm = fmaxf(__uint_as_float(rr_[0]), __uint_as_float(rr_[1])); }
            const float mnew = fmaxf(mrun, rm);
            if (__any(mnew > mrun)) {
                const float alpha = __builtin_amdgcn_exp2f(mrun - mnew);
                lrun *= alpha;
#pragma unroll
                for (int d = 0; d < 4; ++d)
#pragma unroll
                    for (int r = 0; r < 16; ++r) o[d][r] *= alpha;
            }
            mrun = mnew;
            float ps = 0.f;
#pragma unroll
            for (int r = 0; r < 16; ++r) { p0[r] = __builtin_amdgcn_exp2f(p0[r] - mnew); p1[r] = __builtin_amdgcn_exp2f(p1[r] - mnew); ps += p0[r] + p1[r]; }
            lrun += ps;
            bf16x8 pf[4];
            { u32x4 w;
              w.x = pk2(p0[0], p0[1]); w.y = pk2(p0[2], p0[3]); w.z = pk2(p0[4], p0[5]); w.w = pk2(p0[6], p0[7]); pf[0] = __builtin_bit_cast(bf16x8, w);
              w.x = pk2(p0[8], p0[9]); w.y = pk2(p0[10], p0[11]); w.z = pk2(p0[12], p0[13]); w.w = pk2(p0[14], p0[15]); pf[1] = __builtin_bit_cast(bf16x8, w);
              w.x = pk2(p1[0], p1[1]); w.y = pk2(p1[2], p1[3]); w.z = pk2(p1[4], p1[5]); w.w = pk2(p1[6], p1[7]); pf[2] = __builtin_bit_cast(bf16x8, w);
              w.x = pk2(p1[8], p1[9]); w.y = pk2(p1[10], p1[11]); w.z = pk2(p1[12], p1[13]); w.w = pk2(p1[14], p1[15]); pf[3] = __builtin_bit_cast(bf16x8, w); }
            const LAS unsigned char* vb = lds + buf * BUFSZ + VOFF + (4 * hi + (i16 >> 2)) * VPB + (16 * g16 + 4 * (i16 & 3)) * 2;
#pragma unroll
            for (int d = 0; d < 4; ++d)
#pragma unroll
                for (int s = 0; s < 4; ++s) {
                    const s16x4 lo = tr_read(vb + (16 * s) * VPB + d * 64), hh = tr_read(vb + (16 * s + 8) * VPB + d * 64);
                    o[d] = MFMA32(cat8(lo, hh), pf[s], o[d]);
                }
        }
        if (it + 1 < NT) FL_LSTORE(buf ^ 1);
        __syncthreads();
    }
    { auto rr_ = __builtin_amdgcn_permlane32_swap(__float_as_uint(lrun), __float_as_uint(lrun), false, false); lrun = __uint_as_float(rr_[0]) + __uint_as_float(rr_[1]); }
    const float il = 1.f / lrun;
#pragma unroll
    for (int d = 0; d < 4; ++d)
#pragma unroll
        for (int r = 0; r < 16; ++r) o[d][r] *= il;
#undef FL_GLOAD
#undef FL_LSTORE
}

DI void mla_unit(int wv, const Params& P, LAS unsigned char* lds, int u) {
    const int qb = 7 - (u >> 6), bh = u & 63, b = bh >> 3, h = bh & 7;
    const int tid_ = tid_from_wave(wv);
    const int tid = tid_, lane = tid & 63, r32 = lane & 31, hi = lane >> 5;
    const int wid = __builtin_amdgcn_readfirstlane(tid >> 6);
    const int q0 = 256 * qb, qrow = q0 + 32 * wid + r32;
    const size_t tok = (size_t)b * SEQ + qrow;
    const bf16_t* Q = (const bf16_t*)(P.ws + WS_Q); const bf16_t* KV = (const bf16_t*)(P.ws + WS_KV); const bf16_t* SM = (const bf16_t*)(P.ws + WS_SMALL);
    bf16_t* MIX = (bf16_t*)(P.ws + WS_HN);
    const int* pos = (const int*)P.in[1];
    const float qscale = 0.07216878364870322f * LOG2E;
    bf16x8 qf[12];
    const bf16_t* qp = Q + tok * Q_LD + h * 192 + 8 * hi;
#pragma unroll
    for (int s = 0; s < 8; ++s) {
        const u32x4 w = *(const u32x4*)(qp + 16 * s);
        u32x4 o; o.x = pk2(bflo(w.x) * qscale, bfhi(w.x) * qscale); o.y = pk2(bflo(w.y) * qscale, bfhi(w.y) * qscale);
        o.z = pk2(bflo(w.z) * qscale, bfhi(w.z) * qscale); o.w = pk2(bflo(w.w) * qscale, bfhi(w.w) * qscale);
        qf[s] = __builtin_bit_cast(bf16x8, o);
    }
#pragma unroll
    for (int s = 0; s < 2; ++s) {
        const u32x4 w1 = *(const u32x4*)(qp + 16 * (8 + s)), w2 = *(const u32x4*)(qp + 16 * (10 + s));
        float t1[8] = {bflo(w1.x), bfhi(w1.x), bflo(w1.y), bfhi(w1.y), bflo(w1.z), bfhi(w1.z), bflo(w1.w), bfhi(w1.w)};
        float t2[8] = {bflo(w2.x), bfhi(w2.x), bflo(w2.y), bfhi(w2.y), bflo(w2.z), bfhi(w2.z), bflo(w2.w), bfhi(w2.w)};
        float o1[8], o2[8];
        const float* tab = (const float*)((const unsigned char*)P.out + ((size_t)32 << 20)) + tok * 64 + 16 * s + 8 * hi;
        const f32x4 c0 = *(const f32x4*)tab, c1 = *(const f32x4*)(tab + 4), s0 = *(const f32x4*)(tab + 32), s1 = *(const f32x4*)(tab + 36);
        const float csv[8] = {c0.x, c0.y, c0.z, c0.w, c1.x, c1.y, c1.z, c1.w}, snv[8] = {s0.x, s0.y, s0.z, s0.w, s1.x, s1.y, s1.z, s1.w};
#pragma unroll
        for (int jj = 0; jj < 8; ++jj) {
            const float cs = csv[jj], sn = snv[jj];
            o1[jj] = (t1[jj] * cs - t2[jj] * sn) * qscale; o2[jj] = (t2[jj] * cs + t1[jj] * sn) * qscale;
        }
        u32x4 a, c; a.x = pk2(o1[0], o1[1]); a.y = pk2(o1[2], o1[3]); a.z = pk2(o1[4], o1[5]); a.w = pk2(o1[6], o1[7]);
        c.x = pk2(o2[0], o2[1]); c.y = pk2(o2[2], o2[3]); c.z = pk2(o2[4], o2[5]); c.w = pk2(o2[6], o2[7]);
        qf[8 + s] = __builtin_bit_cast(bf16x8, a); qf[10 + s] = __builtin_bit_cast(bf16x8, c);
    }
    f32x16 o[4];
    flash_unit<192, false, true>(wv, lds, qf, KV + (size_t)b * SEQ * KV_LD + h * 256, KV_LD, SM + (size_t)b * SEQ * SMALL_LD, SMALL_LD,
                                 KV + (size_t)b * SEQ * KV_LD + h * 256 + 128, KV_LD, nullptr, q0, 0, 0.f, o);
    bf16_t* op = MIX + tok * DM + h * 128;
#pragma unroll
    for (int d = 0; d < 4; ++d)
#pragma unroll
        for (int g = 0; g < 4; ++g) { u32x2 w; w.x = pk2(o[d][4 * g], o[d][4 * g + 1]); w.y = pk2(o[d][4 * g + 2], o[d][4 * g + 3]); *(u32x2*)(op + 32 * d + 8 * g + 4 * hi) = w; }
}

DI void diff_unit(int wv, const Params& P, LAS unsigned char* lds, int u) {
    const int qb = 7 - (u >> 6), bh = u & 63, b = bh >> 3, h = bh & 7;
    const int tid_ = tid_from_wave(wv);
    const int tid = tid_, lane = tid & 63, r32 = lane & 31, hi = lane >> 5;
    const int wid = __builtin_amdgcn_readfirstlane(tid >> 6);
    const int q0 = 256 * qb, qrow = q0 + 32 * wid + r32;
    const size_t tok = (size_t)b * SEQ + qrow;
    const bf16_t* PR = (const bf16_t*)(P.ws + WS_PROJ);
    bf16_t* MIX = (bf16_t*)(P.ws + WS_HN);
    const int* pos = (const int*)P.in[1];
    const float qscale = 0.125f * LOG2E;
    const float slope_l2 = exp2f(-(float)(h + 1)) * LOG2E;
    const int posq = pos[tok];
    f32x16 o1[4], o2[4];
#pragma unroll
    for (int c = 0; c < 2; ++c) {
        bf16x8 qf[4];
        const bf16_t* qp = PR + tok * PROJ_LD + 1024 + h * 128 + c * 64 + 8 * hi;
#pragma unroll
        for (int s = 0; s < 4; ++s) {
            const u32x4 w = *(const u32x4*)(qp + 16 * s);
            u32x4 o; o.x = pk2(bflo(w.x) * qscale, bfhi(w.x) * qscale); o.y = pk2(bflo(w.y) * qscale, bfhi(w.y) * qscale);
            o.z = pk2(bflo(w.z) * qscale, bfhi(w.z) * qscale); o.w = pk2(bflo(w.w) * qscale, bfhi(w.w) * qscale);
            qf[s] = __builtin_bit_cast(bf16x8, o);
        }
        const bf16_t* kp = PR + (size_t)b * SEQ * PROJ_LD + 2048 + h * 128 + c * 64;
        const bf16_t* vp = PR + (size_t)b * SEQ * PROJ_LD + 3072 + h * 128;
        if (c == 0) {
            flash_unit<64, true, false>(wv, lds, qf, kp, PROJ_LD, nullptr, 0, vp, PROJ_LD, pos + (size_t)b * SEQ, q0, posq, slope_l2, o1);
            LAS float* sv = (LAS float*)(lds + 60160) + tid;
#pragma unroll
            for (int r = 0; r < 16; ++r) { sv[r * 512] = o1[2][r]; sv[(16 + r) * 512] = o1[3][r]; }
            sv[32 * 512] = o1[1][14]; sv[33 * 512] = o1[1][15];
        } else flash_unit<64, true, false>(wv, lds, qf, kp, PROJ_LD, nullptr, 0, vp, PROJ_LD, pos + (size_t)b * SEQ, q0, posq, slope_l2, o2);
    }
    {
        const LAS float* sv = (const LAS float*)(lds + 60160) + tid_from_wave(wv);
#pragma unroll
        for (int r = 0; r < 16; ++r) { o1[2][r] = sv[r * 512]; o1[3][r] = sv[(16 + r) * 512]; }
        o1[1][14] = sv[32 * 512]; o1[1][15] = sv[33 * 512];
    }
    const int tidb = tid_from_wave(wv), laneb = tidb & 63, hib = laneb >> 5;
    const size_t tokb = (size_t)b * SEQ + q0 + 32 * (tidb >> 6) + (laneb & 31);
    float d1 = P.in[28][laneb] * P.in[29][laneb], d2 = P.in[30][laneb] * P.in[31][laneb];
    d1 = wave_sum(d1); d2 = wave_sum(d2);
    const float lam = expf(d1) - expf(d2) + LAMBDA_INIT;
    float ss = 0.f;
#pragma unroll
    for (int d = 0; d < 4; ++d)
#pragma unroll
        for (int r = 0; r < 16; ++r) { const float v = o1[d][r] - lam * o2[d][r]; o1[d][r] = v; ss += v * v; }
    ss += __shfl_xor(ss, 32);
    const float rstd = (1.f / sqrtf(ss * (1.f / 128.f) + RMS_EPS)) * (1.f - LAMBDA_INIT);
    const float* dn = P.in[32];
    bf16_t* op = MIX + tokb * DM + 1024 + h * 128;
#pragma unroll
    for (int d = 0; d < 4; ++d)
#pragma unroll
        for (int g = 0; g < 4; ++g) { const int e = 32 * d + 8 * g + 4 * hib; const f32x4 gg = *(const f32x4*)(dn + e);
            u32x2 w; w.x = pk2(o1[d][4 * g] * rstd * gg.x, o1[d][4 * g + 1] * rstd * gg.y); w.y = pk2(o1[d][4 * g + 2] * rstd * gg.z, o1[d][4 * g + 3] * rstd * gg.w);
            *(u32x2*)(op + e) = w; }
}

constexpr size_t OUT_KH = 0;
constexpr size_t OUT_DEC = (size_t)NTOK * 512 * 2;
constexpr size_t OUT_U = OUT_DEC + (size_t)256 * 512 * 4;
constexpr size_t OUT_DSEG = OUT_U + (size_t)96 * 131072;
constexpr size_t OUT_ROPE = (size_t)32 << 20;
DI float log_sigmoid_(float x) { return fminf(x, 0.f) - __logf(1.f + __expf(-fabsf(x))); }
DI void gla_prep_item(int wv, const Params& P, LAS unsigned char* lds, int item) {
    const int tid_ = tid_from_wave(wv);
    const int tid = tid_;
    const int b = item >> 7, h = (item >> 5) & 3, ch = item & 31;
    bf16_t* PR = (bf16_t*)(P.ws + WS_PROJ); const bf16_t* SM = (const bf16_t*)(P.ws + WS_SMALL);
    bf16_t* KH = (bf16_t*)((unsigned char*)P.out + OUT_KH); float* DEC = (float*)((unsigned char*)P.out + OUT_DEC);
    LAS float* glrs = (LAS float*)lds; LAS float* tots = (LAS float*)(lds + 4096);
    const int d = tid & 127, part = tid >> 7;
    const size_t tok0 = (size_t)b * SEQ + 64 * ch;
    float wg[16];
#pragma unroll
    for (int r = 0; r < 16; ++r) wg[r] = P.in[13][r * 512 + h * 128 + d];
    const float bg = P.in[14][h * 128 + d];
    if (tid < 256) { const int tk = tid >> 2, r0 = (tid & 3) * 4; const u32x2 w = *(const u32x2*)(SM + (tok0 + tk) * SMALL_LD + 64 + r0);
        *(LAS f32x4*)(glrs + tk * 16 + r0) = (f32x4){bflo(w.x), bfhi(w.x), bflo(w.y), bfhi(w.y)}; }
    float qv[16], kv[16];
#pragma unroll
    for (int i = 0; i < 16; ++i) { const size_t a = (tok0 + 16 * part + i) * PROJ_LD + 1024 + h * 128 + d; qv[i] = bf2f(PR[a]); kv[i] = bf2f(PR[a + 512]); }
    __syncthreads();
    float cum[16]; float run = 0.f;
#pragma unroll
    for (int i = 0; i < 16; ++i) {
        const LAS f32x4* gp = (const LAS f32x4*)(glrs + (16 * part + i) * 16);
        const f32x4 g0 = gp[0], g1 = gp[1], g2 = gp[2], g3 = gp[3];
        float x = bg;
        x += g0.x * wg[0] + g0.y * wg[1] + g0.z * wg[2] + g0.w * wg[3];
        x += g1.x * wg[4] + g1.y * wg[5] + g1.z * wg[6] + g1.w * wg[7];
        x += g2.x * wg[8] + g2.y * wg[9] + g2.z * wg[10] + g2.w * wg[11];
        x += g3.x * wg[12] + g3.y * wg[13] + g3.z * wg[14] + g3.w * wg[15];
        run += log_sigmoid_(x) * (1.f / 16.f);
        cum[i] = run;
    }
    tots[part * 128 + d] = run;
    __syncthreads();
    float pre = 0.f, last = 0.f;
#pragma unroll
    for (int pp = 0; pp < 4; ++pp) { const float tv = tots[pp * 128 + d]; if (pp < part) pre += tv; last += tv; }
    if (part == 0) DEC[(size_t)(b * 32 + ch) * 512 + h * 128 + d] = __expf(last);
#pragma unroll
    for (int i = 0; i < 16; ++i) {
        const size_t tk = tok0 + 16 * part + i; const float c = cum[i] + pre;
        PR[tk * PROJ_LD + 1024 + h * 128 + d] = f2bf(qv[i] * __expf(c) * 0.08838834764831845f);
        PR[tk * PROJ_LD + 1536 + h * 128 + d] = f2bf(kv[i] * __expf(-c));
        KH[tk * 512 + h * 128 + d] = f2bf(kv[i] * __expf(last - c));
    }
    __syncthreads();
}

template <bool STATE_ONLY>
DI void gla_unit(int wv, const Params& P, LAS unsigned char* lds, int b, int h, int seg) {
    constexpr int QP = 288, VP2 = 544, PP = 144, OP = 528;
    constexpr int OFF_Q = 0, OFF_K = OFF_Q + 64 * QP, OFF_KH = OFF_K + 64 * QP, OFF_V = OFF_KH + 64 * QP, OFF_P = OFF_V + 64 * VP2;
    constexpr int OFF_DEC = OFF_P + 64 * PP, OFF_SS = OFF_DEC + 128 * 4, OFF_END = OFF_SS + 64 * 8 * 4, OFF_O = 0;
    static_assert(OFF_END <= LDS_RING && 64 * OP <= OFF_KH, "gla lds");
    const int tid_ = tid_from_wave(wv);
    const int tid = tid_, lane = tid & 63, i16 = lane & 15, quad = lane >> 4;
    const int ch0 = 8 * seg, bh = b * 4 + h;
    f32x4* UU = (f32x4*)((unsigned char*)P.out + OUT_U); float* DSEG = (float*)((unsigned char*)P.out + OUT_DSEG);
    const int wid = __builtin_amdgcn_readfirstlane(tid >> 6);
    const bf16_t* PR = (const bf16_t*)(P.ws + WS_PROJ);
    const bf16_t* KH = (const bf16_t*)((const unsigned char*)P.out + OUT_KH); const float* DEC = (const float*)((const unsigned char*)P.out + OUT_DEC);
    bf16_t* MIX = (bf16_t*)(P.ws + WS_HN);
    const int e0 = 32 * wid;
    f32x4 st[8][2];
#pragma unroll
    for (int a = 0; a < 8; ++a)
#pragma unroll
        for (int c = 0; c < 2; ++c) st[a][c] = (f32x4){0.f, 0.f, 0.f, 0.f};
    if (!STATE_ONLY) {
        for (int sg = 0; sg < seg; ++sg) {
            const f32x4* up = UU + ((size_t)(bh * 3 + sg) * 8 + wid) * 1024 + lane;
            const float* dp = DSEG + (size_t)(bh * 3 + sg) * 128 + 4 * quad;
#pragma unroll
            for (int a = 0; a < 8; ++a) { const f32x4 dc = *(const f32x4*)(dp + 16 * a);
                st[a][0] = st[a][0] * dc + up[(a * 2 + 0) * 64]; st[a][1] = st[a][1] * dc + up[(a * 2 + 1) * 64]; }
        }
    }
    float dprod = 1.f;
    const float gn0 = P.in[15][e0 + i16], gn1 = P.in[15][e0 + 16 + i16];
    LAS float* decs = (LAS float*)(lds + OFF_DEC); LAS float* sss = (LAS float*)(lds + OFF_SS);
    u32x4 rq[2], rk[2], rh[2], rv[4]; float rd = 0.f;
    const unsigned oq = (unsigned)((tid >> 4) * PROJ_LD + 8 * (tid & 15)), okh = (unsigned)((tid >> 4) * 512 + 8 * (tid & 15)), ovv = (unsigned)((tid >> 5) * PROJ_LD + 8 * (tid & 31));
    const unsigned omix = (unsigned)((tid >> 5) * DM + 8 * (tid & 31));
#define GLA_GLOAD(ch) do { const size_t t0_ = (size_t)b * SEQ + 64 * (ch); \
        _Pragma("unroll") for (int i_ = 0; i_ < 2; ++i_) { \
            const bf16_t* pq_ = PR + (t0_ + 32 * i_) * PROJ_LD + 1024 + h * 128; const bf16_t* ph_ = KH + (t0_ + 32 * i_) * 512 + h * 128; \
            if (!STATE_ONLY) { rq[i_] = *(const u32x4*)(pq_ + oq); rk[i_] = *(const u32x4*)(pq_ + 512 + oq); } rh[i_] = *(const u32x4*)(ph_ + okh); } \
        if (STATE_ONLY) { _Pragma("unroll") for (int i_ = 0; i_ < 4; ++i_) { const bf16_t* pv_ = PR + (t0_ + 16 * i_) * PROJ_LD + 2048 + h * 256; rv[i_] = *(const u32x4*)(pv_ + ovv); } } \
        if (tid < 128) rd = (DEC + (size_t)(b * 32 + (ch)) * 512 + h * 128)[tid]; } while (0)
    GLA_GLOAD(ch0);
    for (int ch = ch0; ch < ch0 + 8; ++ch) {
        const size_t tok0 = (size_t)b * SEQ + 64 * ch;
#pragma unroll
        for (int i = 0; i < 2; ++i) { const int c = tid + 512 * i, j = c >> 4, cc = c & 15;
            if (!STATE_ONLY) { *(LAS u32x4*)(lds + OFF_Q + j * QP + cc * 16) = rq[i]; *(LAS u32x4*)(lds + OFF_K + j * QP + cc * 16) = rk[i]; } *(LAS u32x4*)(lds + OFF_KH + j * QP + cc * 16) = rh[i]; }
#pragma unroll
        for (int i = 0; i < 4; ++i) { if (!STATE_ONLY) { const bf16_t* pv_ = PR + (tok0 + 16 * i) * PROJ_LD + 2048 + h * 256; rv[i] = *(const u32x4*)(pv_ + ovv); }
            else { const int c = tid + 512 * i, j = c >> 5, cc = c & 31; *(LAS u32x4*)(lds + OFF_V + j * VP2 + cc * 16) = rv[i]; } }
        if (tid < 128) { decs[tid] = rd; dprod *= rd; }
        __syncthreads();
        if (!STATE_ONLY) {
#pragma unroll
        for (int x = 0; x < 2; ++x) {
            const int tl = 2 * wid + x, it = tl >> 2, jt = tl & 3;
            f32x4 acc = (f32x4){0.f, 0.f, 0.f, 0.f};
            if (jt <= it) {
#pragma unroll
                for (int s = 0; s < 4; ++s) {
                    const bf16x8 a = *(const LAS bf16x8*)(lds + OFF_Q + (16 * it + i16) * QP + (32 * s + 8 * quad) * 2);
                    const bf16x8 bb = *(const LAS bf16x8*)(lds + OFF_K + (16 * jt + i16) * QP + (32 * s + 8 * quad) * 2);
                    acc = MFMA16(a, bb, acc);
                }
            }
#pragma unroll
            for (int r = 0; r < 4; ++r) { const int i = 16 * it + 4 * quad + r, j = 16 * jt + i16; const float v = (j <= i) ? acc[r] : 0.f;
                *(LAS bf16_t*)(lds + OFF_P + i * PP + j * 2) = f2bf(v); }
        }
        }
        if (!STATE_ONLY) {
#pragma unroll
        for (int i = 0; i < 4; ++i) { const int c = tid + 512 * i, j = c >> 5, cc = c & 31; *(LAS u32x4*)(lds + OFF_V + j * VP2 + cc * 16) = rv[i]; }
        __syncthreads();
        }
        bf16x8 vf[2][2];
#pragma unroll
        for (int s = 0; s < 2; ++s)
#pragma unroll
            for (int et = 0; et < 2; ++et) {
                const LAS unsigned char* vb = lds + OFF_V + (32 * s + 8 * quad + (i16 >> 2)) * VP2 + (e0 + 16 * et + 4 * (i16 & 3)) * 2;
                vf[s][et] = cat8(tr_read(vb), tr_read(vb + 4 * VP2));
            }
        if (!STATE_ONLY) {
        f32x4 oo[4][2];
#pragma unroll
        for (int it = 0; it < 4; ++it)
#pragma unroll
            for (int et = 0; et < 2; ++et) oo[it][et] = (f32x4){0.f, 0.f, 0.f, 0.f};
#pragma unroll
        for (int s = 0; s < 2; ++s)
#pragma unroll
            for (int it = 0; it < 4; ++it) {
                const bf16x8 a = *(const LAS bf16x8*)(lds + OFF_P + (16 * it + i16) * PP + (32 * s + 8 * quad) * 2);
                oo[it][0] = MFMA16(a, vf[s][0], oo[it][0]); oo[it][1] = MFMA16(a, vf[s][1], oo[it][1]);
                if (it == 3) __builtin_amdgcn_sched_barrier(0);
            }
#pragma unroll
        for (int s = 0; s < 4; ++s) {
            bf16x8 sb[2];
#pragma unroll
            for (int et = 0; et < 2; ++et) { u32x4 w; w.x = pk2(st[2 * s][et][0], st[2 * s][et][1]); w.y = pk2(st[2 * s][et][2], st[2 * s][et][3]);
                w.z = pk2(st[2 * s + 1][et][0], st[2 * s + 1][et][1]); w.w = pk2(st[2 * s + 1][et][2], st[2 * s + 1][et][3]); sb[et] = __builtin_bit_cast(bf16x8, w); }
#pragma unroll
            for (int it = 0; it < 4; ++it) {
                const LAS unsigned char* qa = lds + OFF_Q + (16 * it + i16) * QP + (32 * s + 4 * quad) * 2;
                const u32x2 lo = *(const LAS u32x2*)qa, hh = *(const LAS u32x2*)(qa + 32);
                const bf16x8 a = __builtin_bit_cast(bf16x8, (u32x4){lo.x, lo.y, hh.x, hh.y});
                oo[it][0] = MFMA16(a, sb[0], oo[it][0]); oo[it][1] = MFMA16(a, sb[1], oo[it][1]);
            }
            __builtin_amdgcn_sched_barrier(0);
        }
#pragma unroll
        for (int it = 0; it < 4; ++it)
#pragma unroll
            for (int r = 0; r < 4; ++r) {
                float s2 = dpp_add16(oo[it][0][r] * oo[it][0][r] + oo[it][1][r] * oo[it][1][r]);
                if (i16 == 0) sss[(16 * it + 4 * quad + r) * 8 + wid] = s2;
            }
        __syncthreads();
#pragma unroll
        for (int it = 0; it < 4; ++it)
#pragma unroll
            for (int r = 0; r < 4; ++r) {
                const int i = 16 * it + 4 * quad + r;
                const LAS f32x4* sp = (const LAS f32x4*)(sss + i * 8); const f32x4 s0 = sp[0], s1 = sp[1];
                const float tot = (s0.x + s0.y) + (s0.z + s0.w) + (s1.x + s1.y) + (s1.z + s1.w);
                const float rstd = 1.f / sqrtf(tot * (1.f / 256.f) + RMS_EPS);
                *(LAS bf16_t*)(lds + OFF_O + i * OP + (e0 + i16) * 2) = f2bf(oo[it][0][r] * rstd * gn0);
                *(LAS bf16_t*)(lds + OFF_O + i * OP + (e0 + 16 + i16) * 2) = f2bf(oo[it][1][r] * rstd * gn1);
            }
        }
        if (ch + 1 < ch0 + 8) GLA_GLOAD(ch + 1);
        u32x4 gpre[4];
        if (!STATE_ONLY) {
#pragma unroll
        for (int i = 0; i < 4; ++i) gpre[i] = *(const u32x4*)((PR + (tok0 + 16 * i) * PROJ_LD + 3072 + h * 256) + ovv);
        }
#pragma unroll
        for (int dt = 0; dt < 8; ++dt) {
            const f32x4 dc = *(const LAS f32x4*)(decs + 16 * dt + 4 * quad);
            st[dt][0] *= dc; st[dt][1] *= dc;
#pragma unroll
            for (int s = 0; s < 2; ++s) {
                const LAS unsigned char* kb = lds + OFF_KH + (32 * s + 8 * quad + (i16 >> 2)) * QP + (16 * dt + 4 * (i16 & 3)) * 2;
                const bf16x8 a = cat8(tr_read(kb), tr_read(kb + 4 * QP));
                st[dt][0] = MFMA16(a, vf[s][0], st[dt][0]); st[dt][1] = MFMA16(a, vf[s][1], st[dt][1]);
            }
            if (dt & 1) __builtin_amdgcn_sched_barrier(0);
        }
        __syncthreads();
        if (!STATE_ONLY) {
#pragma unroll
        for (int i = 0; i < 4; ++i) { const int c = tid + 512 * i, row = c >> 5, cc = c & 31;
            const u32x4 ov = *(const LAS u32x4*)(lds + OFF_O + row * OP + cc * 16);
            const u32x4 gv = gpre[i];
            u32x4 w;
            w.x = pk2(bflo(ov.x) * siluf_(bflo(gv.x)), bfhi(ov.x) * siluf_(bfhi(gv.x)));
            w.y = pk2(bflo(ov.y) * siluf_(bflo(gv.y)), bfhi(ov.y) * siluf_(bfhi(gv.y)));
            w.z = pk2(bflo(ov.z) * siluf_(bflo(gv.z)), bfhi(ov.z) * siluf_(bfhi(gv.z)));
            w.w = pk2(bflo(ov.w) * siluf_(bflo(gv.w)), bfhi(ov.w) * siluf_(bfhi(gv.w)));
            *(u32x4*)((MIX + (tok0 + 16 * i) * DM + 1024 + h * 256) + omix) = w; }
        __syncthreads();
        }
    }
    if (STATE_ONLY) {
        f32x4* up = UU + ((size_t)(bh * 3 + seg) * 8 + wid) * 1024 + lane;
#pragma unroll
        for (int a = 0; a < 8; ++a) { up[(a * 2 + 0) * 64] = st[a][0]; up[(a * 2 + 1) * 64] = st[a][1]; }
        if (tid < 128) DSEG[(size_t)(bh * 3 + seg) * 128 + tid] = dprod;
    }
#undef GLA_GLOAD
}

DI float gelu_tanh_(float x) { const float u = 0.7978845608028654f * (x + 0.044715f * x * x * x); const float t = 1.f - 2.f * __builtin_amdgcn_rcpf(__expf(2.f * u) + 1.f); return 0.5f * x * (1.f + t); }
DI void s5_unit(int wv, const Params& P, LAS unsigned char* lds, int item) {
    const int tid_ = tid_from_wave(wv);
    const int tid = tid_, lane = tid & 63, i16 = lane & 15, quad = lane >> 4;
    const int wid = __builtin_amdgcn_readfirstlane(tid >> 6);
    const int pair = item * 8 + wid, b = pair >> 6, g = pair & 63;
    LAS unsigned char* wl = lds + wid * 16384;
    LAS float* bus = (LAS float*)wl;
    LAS unsigned char* xs = wl + 8192;
    bf16_t* PR = (bf16_t*)(P.ws + WS_PROJ);
    const float* a_re = P.in[18]; const float* a_im = P.in[19]; const float* b_re = P.in[21]; const float* b_im = P.in[22];
    const float* c_re = P.in[23]; const float* c_im = P.in[24];
    const float dt = expf(P.in[20][g]);
    float ar, ai;
    { const float lr = a_re[g * 64 + lane], li = a_im[g * 64 + lane]; const float mag = expf(lr * dt); float sn, cs; sincosf(li * dt, &sn, &cs); ar = mag * cs; ai = mag * sn; }
    bf16x8 bfr[8];
#pragma unroll
    for (int k = 0; k < 4; ++k) {
        const int n = 16 * k + i16;
        const float lr = a_re[g * 64 + n], li = a_im[g * 64 + n]; const float mag = expf(lr * dt); float sn, cs; sincosf(li * dt, &sn, &cs);
        const float zr = mag * cs - 1.f, zi = mag * sn, den = lr * lr + li * li;
        const float fr = (zr * lr + zi * li) / den, fi = (zi * lr - zr * li) / den;
        float vr[8], vi[8];
#pragma unroll
        for (int j = 0; j < 8; ++j) { vr[j] = 0.f; vi[j] = 0.f; }
        if (quad < 2) {
            const f32x4 r0 = *(const f32x4*)(b_re + ((size_t)g * 64 + n) * 16 + 8 * quad), r1 = *(const f32x4*)(b_re + ((size_t)g * 64 + n) * 16 + 8 * quad + 4);
            const f32x4 m0 = *(const f32x4*)(b_im + ((size_t)g * 64 + n) * 16 + 8 * quad), m1 = *(const f32x4*)(b_im + ((size_t)g * 64 + n) * 16 + 8 * quad + 4);
            const float br[8] = {r0.x, r0.y, r0.z, r0.w, r1.x, r1.y, r1.z, r1.w}, bi[8] = {m0.x, m0.y, m0.z, m0.w, m1.x, m1.y, m1.z, m1.w};
#pragma unroll
            for (int j = 0; j < 8; ++j) { vr[j] = fr * br[j] - fi * bi[j]; vi[j] = fr * bi[j] + fi * br[j]; }
        }
        u32x4 w; w.x = pk2(vr[0], vr[1]); w.y = pk2(vr[2], vr[3]); w.z = pk2(vr[4], vr[5]); w.w = pk2(vr[6], vr[7]); bfr[k] = __builtin_bit_cast(bf16x8, w);
        w.x = pk2(vi[0], vi[1]); w.y = pk2(vi[2], vi[3]); w.z = pk2(vi[4], vi[5]); w.w = pk2(vi[6], vi[7]); bfr[4 + k] = __builtin_bit_cast(bf16x8, w);
    }
    bf16x8 cfr[4];
#pragma unroll
    for (int s = 0; s < 4; ++s) {
        const float* cp = (s < 2 ? c_re : c_im) + ((size_t)g * 16 + i16) * 64 + 32 * (s & 1) + 8 * quad;
        const f32x4 c0 = *(const f32x4*)cp, c1 = *(const f32x4*)(cp + 4);
        const float sg = s < 2 ? 1.f : -1.f;
        u32x4 w; w.x = pk2(sg * c0.x, sg * c0.y); w.y = pk2(sg * c0.z, sg * c0.w); w.z = pk2(sg * c1.x, sg * c1.y); w.w = pk2(sg * c1.z, sg * c1.w);
        cfr[s] = __builtin_bit_cast(bf16x8, w);
    }
    const float dsk = P.in[25][g * 16 + i16];
    float xr = 0.f, xi = 0.f;
    const bf16_t* ub = PR + (size_t)b * SEQ * PROJ_LD + g * 16;
    bf16_t* zb = (bf16_t*)(P.ws + WS_Q) + (size_t)b * SEQ * Q_LD + g * 16;
    u32x4 ua_n = (u32x4){0u, 0u, 0u, 0u}; bf16_t uv_n[4];
    if (quad < 2) ua_n = *(const u32x4*)(ub + (size_t)i16 * PROJ_LD + 8 * quad);
#pragma unroll
    for (int r = 0; r < 4; ++r) uv_n[r] = ub[(size_t)(4 * quad + r) * PROJ_LD + i16];
    for (int t0 = 0; t0 < SEQ; t0 += 16) {
        const u32x4 ua = ua_n;
        float uv[4];
#pragma unroll
        for (int r = 0; r < 4; ++r) uv[r] = bf2f(uv_n[r]);
        if (t0 + 16 < SEQ) {
            if (quad < 2) ua_n = *(const u32x4*)(ub + (size_t)(t0 + 16 + i16) * PROJ_LD + 8 * quad);
#pragma unroll
            for (int r = 0; r < 4; ++r) uv_n[r] = ub[(size_t)(t0 + 16 + 4 * quad + r) * PROJ_LD + i16];
        }
        const bf16x8 af = __builtin_bit_cast(bf16x8, ua);
#pragma unroll
        for (int nt = 0; nt < 8; ++nt) {
            const f32x4 c = MFMA16(af, bfr[nt], ((f32x4){0.f, 0.f, 0.f, 0.f}));
#pragma unroll
            for (int r = 0; r < 4; ++r) bus[(4 * quad + r) * 128 + 16 * nt + i16] = c[r];
        }
        LDS_WAIT();
        float br_[16], bi_[16];
#pragma unroll
        for (int t = 0; t < 16; ++t) { br_[t] = bus[t * 128 + lane]; bi_[t] = bus[t * 128 + 64 + lane]; }
        LDS_WAIT();
        __builtin_amdgcn_sched_barrier(0);
#pragma unroll
        for (int t = 0; t < 16; ++t) {
            const float nr = ar * xr - ai * xi + br_[t], ni = ar * xi + ai * xr + bi_[t];
            xr = nr; xi = ni; br_[t] = nr; bi_[t] = ni;
        }
        __builtin_amdgcn_sched_barrier(0);
#pragma unroll
        for (int t = 0; t < 16; ++t) {
            *(LAS bf16_t*)(xs + t * 272 + lane * 2) = f2bf(br_[t]);
            *(LAS bf16_t*)(xs + t * 272 + (64 + lane) * 2) = f2bf(bi_[t]);
        }
        LDS_WAIT();
        f32x4 y = (f32x4){0.f, 0.f, 0.f, 0.f};
#pragma unroll
        for (int s = 0; s < 4; ++s) { const bf16x8 a = *(const LAS bf16x8*)(xs + i16 * 272 + (32 * s + 8 * quad) * 2); y = MFMA16(a, cfr[s], y); }
#pragma unroll
        for (int r = 0; r < 4; ++r) { const float yv = y[r] + dsk * uv[r]; zb[(size_t)(t0 + 4 * quad + r) * Q_LD + i16] = f2bf(gelu_tanh_(yv)); }
        LDS_WAIT();
    }
}

#define XB_TMO      128
#define XB_XCNT(j)  (256  + 64 * (j))
#define XB_XSUB(j)  (1280 + 64 * (j))
#define XB_XGEN(j)  (2304 + 64 * (j))
#define XB_TOP      3328
#define XB_TOPGEN   3392
#define XCD_BAR_WORDS 3456
#define XB_SPIN_CAP (1u << 18)
DI unsigned xb_ld(unsigned* p)              { return __hip_atomic_load(p, __ATOMIC_RELAXED, __HIP_MEMORY_SCOPE_AGENT); }
DI unsigned xb_add(unsigned* p, unsigned v) { return __hip_atomic_fetch_add(p, v, __ATOMIC_RELAXED, __HIP_MEMORY_SCOPE_AGENT); }
DI unsigned xb_xcc_id() { return (unsigned)__builtin_amdgcn_s_getreg((3 << 11) | 20) & 0xFu; }
#define XB_SPIN(cond, bar) do { unsigned _sp = 0; while (cond) { __builtin_amdgcn_s_sleep(1); \
    if ((++_sp & 255u) == 0u) { if (xb_ld(&(bar)[XB_TMO])) break; if (_sp > XB_SPIN_CAP) { atomicAdd(&(bar)[XB_TMO], 1u); break; } } } } while (0)
struct XcdBarrier { unsigned* bar; unsigned x; volatile LAS unsigned* st; };
DI XcdBarrier xcd_barrier_post(unsigned* bar, volatile LAS unsigned* st) {
    XcdBarrier b; b.bar = bar; b.x = xb_xcc_id(); b.st = st;
    if (threadIdx.x == 0) (void)xb_add(&bar[XB_XCNT(b.x)], 1u);
    return b;
}
DI void xcd_barrier_complete(unsigned* bar, unsigned x, unsigned& nloc, unsigned& nx) {
    const unsigned G = gridDim.x * gridDim.y * gridDim.z;
    unsigned sum, cnt, mine, sp = 0u;
    for (;;) {
        sum = 0u; cnt = 0u; mine = 0u;
#pragma unroll
        for (unsigned j = 0; j < 16; ++j) { const unsigned c = xb_ld(&bar[XB_XCNT(j)]); sum += c; cnt += (c > 0u) ? 1u : 0u; mine = (j == x) ? c : mine; }
        if (sum == G) break;
        __builtin_amdgcn_s_sleep(1);
        if ((++sp & 255u) == 0u) { if (xb_ld(&bar[XB_TMO])) break; if (sp > XB_SPIN_CAP) { atomicAdd(&bar[XB_TMO], 1u); break; } }
    }
    nloc = mine > 0u ? mine : 1u; nx = cnt > 0u ? cnt : 1u;
}
DI void xcd_barrier(const XcdBarrier& b) {
    asm volatile("s_waitcnt vmcnt(0)" ::: "memory");
    __syncthreads();
    if (threadIdx.x == 0) {
        unsigned* bar = b.bar;
        __builtin_amdgcn_s_waitcnt(0);
        unsigned nloc = b.st[0], nx = b.st[1];
        if (nloc == 0u) { xcd_barrier_complete(bar, b.x, nloc, nx); b.st[0] = nloc; b.st[1] = nx; }
        const unsigned old = xb_add(&bar[XB_XSUB(b.x)], 1u);
        const unsigned gen = old / nloc;
        if (old + 1u == (gen + 1u) * nloc) {
            __builtin_amdgcn_fence(__ATOMIC_RELEASE, "agent");
            asm volatile("s_waitcnt vmcnt(0)" ::: "memory");
            const unsigned og = xb_add(&bar[XB_TOP], 1u);
            const unsigned tg = og / nx;
            if (og + 1u == (tg + 1u) * nx) xb_add(&bar[XB_TOPGEN], 1u);
            else XB_SPIN(xb_ld(&bar[XB_TOPGEN]) == tg, bar);
            __builtin_amdgcn_fence(__ATOMIC_ACQUIRE, "agent");
            xb_add(&bar[XB_XGEN(b.x)], 1u);
            asm volatile("s_waitcnt vmcnt(0)" ::: "memory");
        } else {
            XB_SPIN(xb_ld(&bar[XB_XGEN(b.x)]) == gen, bar);
            __builtin_amdgcn_fence(__ATOMIC_ACQUIRE, "agent");
            asm volatile("s_waitcnt vmcnt(0)" ::: "memory");
        }
    }
    __syncthreads();
}

#ifndef FUSED
#define FUSED 1
#endif
#ifndef DUP_PHASE
#define DUP_PHASE -1
#endif
#ifndef DUP_SUB
#define DUP_SUB 0
#endif
#ifndef EXTRA_SYNCS
#define EXTRA_SYNCS 0
#endif

template <int PH, int REP = 0> DI void run_phase(int wv, const Params& P, LAS unsigned char* lds) {
    const int tid_ = tid_from_wave(wv);
    const int tid = tid_, lane = tid & 63, wave = __builtin_amdgcn_readfirstlane(tid >> 6);
    const int G = gridDim.x, bid = blockIdx.x;
    const int gw = bid * 8 + wave, ngw = G * 8;
    unsigned char* ws = P.ws;
    unsigned* ctl = (unsigned*)(ws + WS_CTL);
    LAS int* qslot = (LAS int*)(lds + MISC_OFF);
    bf16_t* HN = (bf16_t*)(ws + WS_HN); bf16_t* PROJ = (bf16_t*)(ws + WS_PROJ); bf16_t* SMALL = (bf16_t*)(ws + WS_SMALL);
    bf16_t* QB = (bf16_t*)(ws + WS_Q); bf16_t* KVB = (bf16_t*)(ws + WS_KV); bf16_t* ACT = (bf16_t*)(ws + WS_ACT);
    float* H = P.out; float* SS = (float*)(ws + WS_SS);
    if constexpr (PH == 0) {
        if (bid == 0 && tid < 8) ctl[32 * tid] = 0u;
        p0_prologue(P, lds, gw, ngw, wave, lane);
    } else if constexpr (PH == 1) {
        pg8::Gemm g{HN, (const bf16_t*)(ws + WS_WIN0), NTOK, NIN0, DM, DM}; pg8::StaticOrder S; S.init(NTOK, NIN0, G, bid);
        pg8::EpiBf16 E{PROJ, PROJ_LD, 16, SMALL, SMALL_LD, nullptr}; pg8::gemm_phase(lds, g, S, E, wv);
    } else if constexpr (PH == 2) {
        p2_rowpass(P, gw, ngw, lane);
        for (int it = bid; it < 1024; it += G) gla_prep_item(wv, P, lds, it);
    } else if constexpr (PH == 3) {
        { pg8::Gemm g{PROJ, (const bf16_t*)(ws + WS_WUQ), NTOK, 1536, 512, PROJ_LD}; pg8::StaticOrder S; S.init(NTOK, 1536, G, bid);
          pg8::EpiBf16 E{QB, Q_LD, 1 << 30, nullptr, 0, nullptr}; pg8::gemm_phase(lds, g, S, E, wv); }
        { pg8::Gemm g{PROJ + 512, (const bf16_t*)(ws + WS_WUKV), NTOK, 2048, 512, PROJ_LD}; pg8::StaticOrder S; S.init(NTOK, 2048, G, bid);
          pg8::EpiBf16 E{KVB, KV_LD, 1 << 30, nullptr, 0, nullptr}; pg8::gemm_phase(lds, g, S, E, wv); }
        { const int shift = (G >= 224) ? 128 : 0;
          for (int it = bid - shift; it >= 0 && it < 96; it += G) { const int bh = it / 3, sg = it - bh * 3; gla_unit<true>(wv, P, lds, bh >> 2, bh & 3, sg); } }
    } else if constexpr (PH == 4) {
        if (REP == 0 || DUP_SUB != 1) for (;;) {
            if (tid_from_wave(wv) == 0) *qslot = (int)atomicAdd(ctl + 32 + 128 * REP, 1u);
            __syncthreads();
            const int item = *qslot;
            __syncthreads();
            if (item >= 128) break;
            { const int sg = 3 - (item >> 5), bh = item & 31; gla_unit<false>(wv, P, lds, bh >> 2, bh & 3, sg); }
        }
        if (REP == 0 || DUP_SUB != 2) for (;;) {
            if (tid_from_wave(wv) == 0) *qslot = (int)atomicAdd(ctl + 0 + 128 * REP, 1u);
            __syncthreads();
            const int item = *qslot;
            __syncthreads();
            if (item >= 512) break;
            mla_unit(wv, P, lds, item);
        }
    } else if constexpr (PH == 5 || PH == 13) {
        pg8::Gemm g{HN, (const bf16_t*)(ws + (PH == 5 ? WS_WOUT0 : WS_WOUT1)), NTOK, DM, DM, DM}; pg8::StaticOrder S; S.init(NTOK, DM, G, bid);
        pg8::EpiResF32 E{PH == 5 ? P.in[0] : H, H, DM, KVB, SS + (PH == 5 ? 0 : 2) * NTOK}; pg8::gemm_phase(lds, g, S, E, wv);
    } else if constexpr (PH == 7 || PH == 15) {
        pg8::Gemm g{KVB, (const bf16_t*)(ws + (PH == 7 ? WS_WGU0 : WS_WGU1)), NTOK, 2 * FFH, DM, DM}; pg8::StaticOrder S; S.init(NTOK, 2 * FFH, G, bid);
        if (REP == 1 && DUP_SUB == 9) { pg8::EpiNone E{}; pg8::gemm_phase(lds, g, S, E, wv); } else {
        pg8::EpiSwiGLU E{ACT, FFH, SS + (PH == 7 ? 0 : 2) * NTOK}; pg8::gemm_phase(lds, g, S, E, wv); }
    } else if constexpr (PH == 8 || PH == 16) {
        pg8::Gemm g{ACT, (const bf16_t*)(ws + (PH == 8 ? WS_WDN0 : WS_WDN1)), NTOK, DM, FFH, FFH}; pg8::StaticOrder S; S.init(NTOK, DM, G, bid);
        pg8::EpiResF32 E{H, H, DM, PH == 8 ? KVB : nullptr, SS + (PH == 8 ? 1 : 3) * NTOK}; pg8::gemm_phase(lds, g, S, E, wv);
    } else if constexpr (PH == 10) {
        pg8::Gemm g{KVB, (const bf16_t*)(ws + WS_WIN1), NTOK, 4096, DM, DM}; pg8::StaticOrder S; S.init(NTOK, 4096, G, bid);
        pg8::EpiBf16 E{PROJ, PROJ_LD, 1 << 30, nullptr, 0, SS + 1 * NTOK}; pg8::gemm_phase(lds, g, S, E, wv);
    } else if constexpr (PH == 11) {
        if (REP == 0 || DUP_SUB != 1) for (;;) {
            if (tid_from_wave(wv) == 0) *qslot = (int)atomicAdd(ctl + 96 + 128 * REP, 1u);
            __syncthreads();
            const int item = *qslot;
            __syncthreads();
            if (item >= 64) break;
            s5_unit(wv, P, lds, item);
        }
        if (REP == 0 || DUP_SUB != 2) for (;;) {
            if (tid_from_wave(wv) == 0) *qslot = (int)atomicAdd(ctl + 64 + 128 * REP, 1u);
            __syncthreads();
            const int item = *qslot;
            __syncthreads();
            if (item >= 512) break;
            diff_unit(wv, P, lds, item);
        }
    } else if constexpr (PH == 12) {
        pg8::Gemm g{QB, (const bf16_t*)(ws + WS_WGLU), NTOK, 1024, 1024, Q_LD}; pg8::StaticOrder S; S.init(NTOK, 1024, G, bid);
        pg8::EpiGLU E{QB, Q_LD, P.in[27], HN, DM}; pg8::gemm_phase(lds, g, S, E, wv);
    } else if constexpr (PH == 17) {
        final_norm_phase(H, P.in[4], SS + 3 * NTOK, gw, ngw, lane);
    }
}

#if FUSED
__global__ void __launch_bounds__(512, 2) hybrid_fwd(Params P) {
    extern __shared__ __attribute__((aligned(16))) unsigned char lds_raw[];
    LAS unsigned char* lds = (LAS unsigned char*)lds_raw;
    cg::grid_group grid = cg::this_grid();
    const int wv = __builtin_amdgcn_readfirstlane((int)threadIdx.x >> 6);
    { LAS unsigned* misc = (LAS unsigned*)(lds + MISC_OFF); if (threadIdx.x < 16) misc[threadIdx.x] = 0u; }
    __syncthreads();
    const XcdBarrier xbar = xcd_barrier_post((unsigned*)(P.ws + WS_CTL) + 4096, (volatile LAS unsigned*)(lds + MISC_OFF + 32));
    if (P.ws == nullptr) grid.sync();
#define SEAM(k) xcd_barrier(xbar)
#define PHASE(k) run_phase<k>(wv, P, lds); SEAM(k); if (DUP_PHASE == k) { run_phase<k, 1>(wv, P, lds); SEAM(k); }
    PHASE(0) PHASE(1) PHASE(2) PHASE(3) PHASE(4) PHASE(5) PHASE(7) PHASE(8)
    PHASE(10) PHASE(11) PHASE(12) PHASE(13) PHASE(15) PHASE(16)
    for (int i_ = 0; i_ < EXTRA_SYNCS; ++i_) xcd_barrier(xbar);
    run_phase<17>(wv, P, lds);
#undef PHASE
}
#else
template <int PH> __global__ void __launch_bounds__(512, 2) phase_kernel(Params P) {
    extern __shared__ __attribute__((aligned(16))) unsigned char lds_raw[];
    run_phase<PH>(__builtin_amdgcn_readfirstlane((int)threadIdx.x >> 6), P, (LAS unsigned char*)lds_raw);
}
template <int PH> static void launch_phase(const Params& p, int grid, hipStream_t stream) {
    (void)hipFuncSetAttribute((const void*)phase_kernel<PH>, hipFuncAttributeMaxDynamicSharedMemorySize, LDS_BYTES);
    hipLaunchKernelGGL(phase_kernel<PH>, dim3(grid), dim3(512), LDS_BYTES, stream, p);
}
#endif

extern "C" void kernel_launch(void* const* d_in, const int* in_sizes, int n_in, void* d_out, int out_size, void* d_ws, size_t ws_size, hipStream_t stream) {
    static int grid = 0;
    if (grid == 0) {
        if (n_in != 34 || out_size != NTOK * DM || ws_size < WS_END) { fprintf(stderr, "kernel_launch: unexpected shapes n_in %d out %d ws %zu (need %zu)\n", n_in, out_size, ws_size, (size_t)WS_END); grid = -1; return; }
        int dev = 0, cus = 0;
        (void)hipGetDevice(&dev);
        (void)hipDeviceGetAttribute(&cus, hipDeviceAttributeMultiprocessorCount, dev);
#if FUSED
        int per_cu = 0;
        (void)hipFuncSetAttribute((const void*)hybrid_fwd, hipFuncAttributeMaxDynamicSharedMemorySize, LDS_BYTES);
        (void)hipOccupancyMaxActiveBlocksPerMultiprocessor(&per_cu, (const void*)hybrid_fwd, 512, LDS_BYTES);
        if (per_cu < 1) fprintf(stderr, "kernel_launch: occupancy query says %d blocks per CU\n", per_cu);
#endif
        (void)hipGetLastError();
        grid = cus;
    }
    if (grid < 0) return;
    Params p{};
    for (int i = 0; i < 34; ++i) p.in[i] = (const float*)d_in[i];
    p.out = (float*)d_out; p.ws = (unsigned char*)d_ws;
#if FUSED
    if (hipMemsetAsync((char*)d_ws + WS_CTL, 0, 32768, stream) != hipSuccess) { fprintf(stderr, "kernel_launch: memset of control words failed\n"); return; }
    void* args[] = {&p};
    hipError_t e = hipLaunchCooperativeKernel((const void*)hybrid_fwd, dim3(grid), dim3(512), args, LDS_BYTES, stream);
    if (e != hipSuccess) fprintf(stderr, "cooperative launch failed: %s (grid %d)\n", hipGetErrorString(e), grid);
#else
    launch_phase<0>(p, grid, stream); launch_phase<1>(p, grid, stream); launch_phase<2>(p, grid, stream); launch_phase<3>(p, grid, stream);
    launch_phase<4>(p, grid, stream); launch_phase<5>(p, grid, stream); launch_phase<6>(p, grid, stream); launch_phase<7>(p, grid, stream);
    launch_phase<8>(p, grid, stream); launch_phase<9>(p, grid, stream); launch_phase<10>(p, grid, stream); launch_phase<11>(p, grid, stream);
    launch_phase<12>(p, grid, stream); launch_phase<13>(p, grid, stream); launch_phase<14>(p, grid, stream); launch_phase<15>(p, grid, stream);
    launch_phase<16>(p, grid, stream); launch_phase<17>(p, grid, stream);
#endif
}
```
